# Optimizing an MI355X kernel written in HIP

```python
import jax, jax.numpy as jnp
from jax import lax
import numpy as np

D_MODEL = 1024
BATCH = 4
SEQ = 8192
DEPTH = 4

N_META = 16
N_HEADS = 16
HEAD_DIM = D_MODEL // N_HEADS
D_FF = 4 * D_MODEL
CONV_WIDTH = 3
BLOCK_Q = 128
N_A_LAYERS = DEPTH // 2
N_B_LAYERS = DEPTH - N_A_LAYERS
N_NORMS = 4
RMS_EPS = 1e-6
NORM_NOISE = 0.02

kernel_name = "yoco_shortconv_stickbreaking_hybrid"


def rms_norm(x, g):
    xf = x.astype(jnp.float32)
    y = xf * lax.rsqrt(jnp.mean(xf * xf, axis=-1, keepdims=True) + RMS_EPS)
    return (y * g.astype(jnp.float32)).astype(x.dtype)


def short_conv_mixer(h, w_in, conv_w, w_out):
    L = h.shape[1]
    b_gate, c_gate, xv = jnp.split(h @ w_in, 3, axis=-1)
    u = c_gate * xv
    u_pad = jnp.pad(u, ((0, 0), (CONV_WIDTH - 1, 0), (0, 0)))
    conv = u_pad[:, 0:L] * conv_w[0]
    for tap in range(1, CONV_WIDTH):
        conv = conv + u_pad[:, tap:tap + L] * conv_w[tap]
    return (b_gate * conv) @ w_out


def squared_relu_mlp(h, w1, w2):
    return jnp.square(jax.nn.relu(h @ w1)) @ w2


def stick_breaking_attention(q, k, v):
    L = q.shape[2]
    pad = (-N_META) % BLOCK_Q
    widths = ((0, 0), (0, 0), (pad, 0), (0, 0))
    qp, kp, vp = jnp.pad(q, widths), jnp.pad(k, widths), jnp.pad(v, widths)
    n_blocks = (L + pad) // BLOCK_Q
    scale = HEAD_DIM ** -0.5
    outs = []
    for i in range(n_blocks):
        q_lo = i * BLOCK_Q
        kv_hi = q_lo + BLOCK_Q
        qb = qp[:, :, q_lo:kv_hi]
        kb = kp[:, :, :kv_hi]
        vb = vp[:, :, :kv_hi]
        z = jnp.einsum('bhqd,bhkd->bhqk', qb, kb).astype(jnp.float32) * scale
        q_pos = q_lo + jnp.arange(BLOCK_Q)[:, None]
        k_pos = jnp.arange(kv_hi)[None, :]
        visible = (k_pos < q_pos) & (k_pos >= pad)
        log_beta = jax.nn.log_sigmoid(z)
        log_one_minus = jnp.where(visible, jax.nn.log_sigmoid(-z), 0.0)
        rev = lax.cumsum(log_one_minus, axis=3, reverse=True)
        after = jnp.pad(rev[..., 1:], ((0, 0), (0, 0), (0, 0), (0, 1)))
        a = jnp.where(visible, jnp.exp(log_beta + after), 0.0)
        outs.append(jnp.einsum('bhqk,bhkd->bhqd', a.astype(vb.dtype), vb))
    return jnp.concatenate(outs, axis=2)[:, :, pad:]


def setup_inputs(seed: int = 0) -> dict:
    key = jax.random.key(seed)
    ks = jax.random.split(key, 14)
    nA, nB = N_A_LAYERS, N_B_LAYERS
    f32 = jnp.float32
    dm = D_MODEL ** -0.5
    return {
        "x": jax.random.normal(ks[0], (BATCH, SEQ, D_MODEL), f32),
        "meta_tokens": jax.random.normal(ks[1], (N_META, D_MODEL), f32),
        "norm_gains": 1.0 + NORM_NOISE * jax.random.normal(ks[2], (DEPTH, N_NORMS, D_MODEL), f32),
        "conv_in_proj": jax.random.normal(ks[3], (nA, D_MODEL, 3 * D_MODEL), f32) * dm,
        "conv_w": jax.random.normal(ks[4], (nA, CONV_WIDTH, D_MODEL), f32) * CONV_WIDTH ** -0.5,
        "conv_out_proj": jax.random.normal(ks[5], (nA, D_MODEL, D_MODEL), f32) * dm,
        "kv_norm": 1.0 + NORM_NOISE * jax.random.normal(ks[6], (D_MODEL,), f32),
        "w_k": jax.random.normal(ks[7], (D_MODEL, D_MODEL), f32) * dm,
        "w_v": jax.random.normal(ks[8], (D_MODEL, D_MODEL), f32) * dm,
        "w_q": jax.random.normal(ks[9], (nB, D_MODEL, D_MODEL), f32) * dm,
        "w_o": jax.random.normal(ks[10], (nB, D_MODEL, D_MODEL), f32) * dm,
        "mlp_w1": jax.random.normal(ks[11], (DEPTH, D_MODEL, D_FF), f32) * dm,
        "mlp_w2": jax.random.normal(ks[12], (DEPTH, D_FF, D_MODEL), f32) * D_FF ** -0.5,
    }


def reference(x, meta_tokens, norm_gains, conv_in_proj, conv_w, conv_out_proj,
              kv_norm, w_k, w_v, w_q, w_o, mlp_w1, mlp_w2):
    bsz = x.shape[0]
    meta = jnp.broadcast_to(meta_tokens[None].astype(x.dtype), (bsz, N_META, D_MODEL))
    h = jnp.concatenate([meta, x], axis=1)
    L = h.shape[1]

    def split_heads(t):
        return t.reshape(bsz, L, N_HEADS, HEAD_DIM).transpose(0, 2, 1, 3)

    k_shared = v_shared = None
    for layer in range(DEPTH):
        g = norm_gains[layer]
        if layer < N_A_LAYERS:
            mix = short_conv_mixer(rms_norm(h, g[0]), conv_in_proj[layer], conv_w[layer],
                                   conv_out_proj[layer])
        else:
            if layer == N_A_LAYERS:
                hk = rms_norm(h, kv_norm)
                k_shared = split_heads(hk @ w_k)
                v_shared = split_heads(hk @ w_v)
            j = layer - N_A_LAYERS
            q = split_heads(rms_norm(h, g[0]) @ w_q[j])
            o = stick_breaking_attention(q, k_shared, v_shared)
            mix = o.transpose(0, 2, 1, 3).reshape(bsz, L, D_MODEL) @ w_o[j]
        h = h + rms_norm(mix, g[1])
        ff = squared_relu_mlp(rms_norm(h, g[2]), mlp_w1[layer], mlp_w2[layer])
        h = h + rms_norm(ff, g[3])
    return h[:, N_META:]
```

```cpp
#include <hip/hip_runtime.h>
#include <cstdio>
#include <cstdint>
namespace pg8 {
#define PG8_LAS __attribute__((address_space(3)))
typedef unsigned short bf16_t;
typedef short bf16x8 __attribute__((ext_vector_type(8)));
typedef float f32x4 __attribute__((ext_vector_type(4)));
typedef unsigned u32x4 __attribute__((ext_vector_type(4)));
constexpr int BM = 256, BK = 64, HALF = 128, HTB = HALF * BK * 2  , STAGE_BYTES = 8 * HTB, NXCD = 8, WGM = 8;

__host__ __device__ __forceinline__ int lds_byte(int r, int c) { const int st = (r >> 4) * 2 + (c >> 5), rr = r & 15, cc = c & 31, ob = rr * 64 + cc * 2; return st * 1024 + (ob ^ (((ob >> 9) & 1) << 5)); }
__host__ __device__ __forceinline__ void stage_rc(int b, int& R, int& C) { const int st = b / 1024, sb = b % 1024, swz = sb ^ (((sb >> 9) & 1) << 5); R = (st >> 1) * 16 + swz / 64; C = (st & 1) * 32 + (swz % 64) / 2; }
__host__ __device__ __forceinline__ int perm32(int rho) { const int n = rho >> 4, i = rho & 15; return 8 * (i >> 2) + 4 * n + (i & 3); }

struct Unit { int pm, pn; };
struct Gemm { const bf16_t* A; const bf16_t* Bt; int M, N, K; };

struct StaticOrder {
    int nM, nN, nwg, G, c;
    __host__ __device__ void init(int M, int N, int G_, int c_) { nM = M / BM; nN = N / BM; nwg = nM * nN; G = G_; c = c_; }
    __host__ __device__ bool next(int i, Unit& u) const {
        const long L = (long)i * G + c; if (L >= nwg) return false;
        int wgid = (int)L; { const int q = nwg / NXCD, r = nwg % NXCD, xcd = wgid % NXCD, off = wgid / NXCD; wgid = (xcd < r ? xcd * (q + 1) : r * (q + 1) + (xcd - r) * q) + off; }
        const int nig = WGM * nN, gid = wgid / nig, fm = gid * WGM, gsz = (nM - fm) < WGM ? (nM - fm) : WGM;
        u.pm = fm + ((wgid % nig) % gsz); u.pn = (wgid % nig) / gsz; return true;
    }
    __device__ __forceinline__ void a_ready(const Unit&) const {}
    __device__ __forceinline__ void done(const Unit&) const {}
};

__device__ __forceinline__ unsigned cvt_pk_bf16(float lo, float hi) { unsigned r; asm volatile("v_cvt_pk_bf16_f32 %0, %1, %2" : "=v"(r) : "v"(lo), "v"(hi)); return r; }
__device__ __forceinline__ u32x4 pack8(const f32x4 v0, const f32x4 v1) { u32x4 w; w.x = cvt_pk_bf16(v0[0], v0[1]); w.y = cvt_pk_bf16(v0[2], v0[3]); w.z = cvt_pk_bf16(v1[0], v1[1]); w.w = cvt_pk_bf16(v1[2], v1[3]); return w; }
struct EpiPlain {
    static constexpr bool PERM = true, AFTER_DRAIN = false;
    bf16_t* O; int ldc; int split_cols; long split_stride;
    __device__ __forceinline__ void operator()(const f32x4 (&acc)[2][2][4][2], const Unit& u, int wr, int wc, int fr, int fq) const {
        const int row0 = u.pm * BM + wr * 64 + fr; int colt = u.pn * BM; bf16_t* base = O;
        if (split_cols) { const int t = colt / split_cols; base += (long)t * split_stride; colt -= t * split_cols; }
        const int col0 = colt + wc * 32 + 8 * fq;
#pragma unroll
        for (int ai = 0; ai < 2; ++ai)
#pragma unroll
            for (int m = 0; m < 4; ++m) { bf16_t* rowp = base + (size_t)(row0 + ai * HALF + m * 16) * ldc + col0;
#pragma unroll
                for (int bj = 0; bj < 2; ++bj) *(u32x4*)(rowp + bj * HALF) = pack8(acc[ai][bj][m][0], acc[ai][bj][m][1]); }
    }
};
struct EpiRelu2 {
    static constexpr bool PERM = true, AFTER_DRAIN = false;
    bf16_t* O; int ldc;
    __device__ __forceinline__ void operator()(const f32x4 (&acc)[2][2][4][2], const Unit& u, int wr, int wc, int fr, int fq) const {
        const int row0 = u.pm * BM + wr * 64 + fr; const int col0 = u.pn * BM + wc * 32 + 8 * fq;
#pragma unroll
        for (int ai = 0; ai < 2; ++ai)
#pragma unroll
            for (int m = 0; m < 4; ++m) { bf16_t* rowp = O + (size_t)(row0 + ai * HALF + m * 16) * ldc + col0;
#pragma unroll
                for (int bj = 0; bj < 2; ++bj) { f32x4 v0 = acc[ai][bj][m][0], v1 = acc[ai][bj][m][1];
#pragma unroll
                    for (int e = 0; e < 4; ++e) { const float a = fmaxf(v0[e], 0.f), b = fmaxf(v1[e], 0.f); v0[e] = a * a; v1[e] = b * b; }
                    *(u32x4*)(rowp + bj * HALF) = pack8(v0, v1); } }
    }
};
struct EpiConvIn {
    static constexpr bool PERM = true, AFTER_DRAIN = false;
    bf16_t* Bo; bf16_t* Uo;
    __device__ __forceinline__ void operator()(const f32x4 (&acc)[2][2][4][2], const Unit& u, int wr, int wc, int fr, int fq) const {
        const int row0 = u.pm * BM + wr * 64 + fr;
        if (u.pn < 4) {
            const int col0 = u.pn * BM + wc * 32 + 8 * fq;
#pragma unroll
            for (int ai = 0; ai < 2; ++ai)
#pragma unroll
                for (int m = 0; m < 4; ++m) { bf16_t* rowp = Bo + (size_t)(row0 + ai * HALF + m * 16) * 1024 + col0;
#pragma unroll
                    for (int bj = 0; bj < 2; ++bj) *(u32x4*)(rowp + bj * HALF) = pack8(acc[ai][bj][m][0], acc[ai][bj][m][1]); }
        } else {
            const int col0 = (u.pn - 4) * HALF + wc * 32 + 8 * fq;
#pragma unroll
            for (int ai = 0; ai < 2; ++ai)
#pragma unroll
                for (int m = 0; m < 4; ++m) { bf16_t* rowp = Uo + (size_t)(row0 + ai * HALF + m * 16) * 1024 + col0;
                    *(u32x4*)rowp = pack8(acc[ai][0][m][0] * acc[ai][1][m][0], acc[ai][0][m][1] * acc[ai][1][m][1]); }
        }
    }
};
template <class Epi, class Sched, bool ALIGN_EPI = false, bool SP2 = false>
__device__ __forceinline__ void gemm_phase(PG8_LAS unsigned char* lds, const Gemm g, const Sched& S, const Epi& E) {
    int tid_ = threadIdx.x; asm volatile("" : "+v"(tid_));
    const int tid = tid_, wid = __builtin_amdgcn_readfirstlane(tid >> 6), lane = tid & 63, wr = wid >> 2, wc = wid & 3, fr = lane & 15, fq = lane >> 4;
    const int K = g.K, nt = K / BK;
    unsigned voffA[2], voffB[2];
#pragma unroll
    for (int i = 0; i < 2; ++i) { int R, C; stage_rc(tid * 16 + i * 8192, R, C); const int Rb = Epi::PERM ? ((R & ~31) + perm32(R & 31)) : R;
        voffA[i] = (unsigned)(R * K + C) * 2u; voffB[i] = (unsigned)(Rb * K + C) * 2u; }
    const size_t kstep = (size_t)(BK * 2);
    const size_t hstep = (size_t)HALF * K * 2;
    const size_t tstep = 2 * hstep;
    const unsigned ldsw = (unsigned)wid * 1024u;
    const int aoff = lds_byte(wr * 64 + fr, fq * 8), boff = lds_byte(wc * 32 + fr, fq * 8);
#define PG8_SA(b, h) (((b) * 2 + (h)) * HTB)
#define PG8_SB(b, h) ((4 + (b) * 2 + (h)) * HTB)
#define PG8_STAGE(bufoff, gbase, voff) do { _Pragma("unroll") for (int _i = 0; _i < 2; ++_i) \
        __builtin_amdgcn_global_load_lds((const unsigned*)((const char*)(gbase) + (voff)[_i]), (PG8_LAS unsigned*)(lds + (bufoff) + ldsw + _i * 8192), 16, 0, 0); } while (0)
#define PG8_LDA(dst, b, h) do { _Pragma("unroll") for (int m = 0; m < 4; ++m) _Pragma("unroll") for (int k = 0; k < 2; ++k) dst[m][k] = *(const PG8_LAS bf16x8*)(lds + PG8_SA(b, h) + aoff + m * 2048 + k * 1024); } while (0)
#define PG8_LDB(dst, b, h) do { _Pragma("unroll") for (int n = 0; n < 2; ++n) _Pragma("unroll") for (int k = 0; k < 2; ++k) dst[n][k] = *(const PG8_LAS bf16x8*)(lds + PG8_SB(b, h) + boff + n * 2048 + k * 1024); } while (0)
#define PG8_MMA(ai, bj, At, Bt) do { __builtin_amdgcn_s_setprio(1); _Pragma("unroll") for (int m = 0; m < 4; ++m) _Pragma("unroll") for (int n = 0; n < 2; ++n) _Pragma("unroll") for (int k = 0; k < 2; ++k) \
        acc[ai][bj][m][n] = __builtin_amdgcn_mfma_f32_16x16x32_bf16(Bt[n][k], At[m][k], acc[ai][bj][m][n], 0, 0, 0); __builtin_amdgcn_s_setprio(0); } while (0)
#define PG8_WAIT_V(n) asm volatile("s_waitcnt vmcnt(" #n ")" ::: "memory")
#define PG8_WAIT_L(n) asm volatile("s_waitcnt lgkmcnt(" #n ")" ::: "memory")
#define PG8_BAR __builtin_amdgcn_s_barrier()
#define PG8_SCHED __builtin_amdgcn_sched_barrier(0)
    Unit cur, nxt; int ui = 0;
    if (!S.next(0, cur)) return;
    f32x4 acc[2][2][4][2];
#pragma unroll
    for (int a = 0; a < 2; ++a)
#pragma unroll
        for (int b = 0; b < 2; ++b)
#pragma unroll
            for (int m = 0; m < 4; ++m)
#pragma unroll
                for (int n = 0; n < 2; ++n) acc[a][b][m][n] = (f32x4){0.f, 0.f, 0.f, 0.f};
    bf16x8 At[4][2], B0[2][2], B1[2][2];
    const char* cA = (const char*)g.A + (size_t)cur.pm * tstep; const char* cB = (const char*)g.Bt + (size_t)cur.pn * tstep;
    S.a_ready(cur);
    if constexpr (SP2) {
        PG8_STAGE(PG8_SB(0, 0), cB, voffB); PG8_STAGE(PG8_SB(0, 1), cB + hstep, voffB); PG8_STAGE(PG8_SA(0, 0), cA, voffA); PG8_STAGE(PG8_SA(0, 1), cA + hstep, voffA);
        if (wr == 1) PG8_BAR;
        PG8_WAIT_V(2); PG8_BAR;
        PG8_STAGE(PG8_SB(1, 0), cB + kstep, voffB); PG8_STAGE(PG8_SA(1, 0), cA + kstep, voffA); PG8_STAGE(PG8_SB(1, 1), cB + hstep + kstep, voffB);
        PG8_WAIT_V(6); PG8_BAR;
    } else {
        PG8_STAGE(PG8_SB(0, 0), cB, voffB); PG8_STAGE(PG8_SA(0, 0), cA, voffA); PG8_STAGE(PG8_SB(0, 1), cB + hstep, voffB); PG8_STAGE(PG8_SA(0, 1), cA + hstep, voffA);
        if (wr == 1) PG8_BAR;
        PG8_WAIT_V(4); PG8_BAR;
        PG8_STAGE(PG8_SB(1, 0), cB + kstep, voffB); PG8_STAGE(PG8_SA(1, 0), cA + kstep, voffA); PG8_STAGE(PG8_SB(1, 1), cB + hstep + kstep, voffB);
        PG8_WAIT_V(6); PG8_BAR;
    }
    for (;;) {
        const bool has_next = S.next(ui + 1, nxt);
        const char* nA = has_next ? (const char*)g.A + (size_t)nxt.pm * tstep : cA; const char* nB = has_next ? (const char*)g.Bt + (size_t)nxt.pn * tstep : cB;
        for (int t = 0; t < nt; t += 2) {
            const bool last = (t == nt - 2);
            const char* a1 = cA + (size_t)(t + 1) * kstep;
            const char* a2 = last ? nA : cA + (size_t)(t + 2) * kstep; const char* b2 = last ? nB : cB + (size_t)(t + 2) * kstep;
            const char* a3 = a2 + kstep; const char* b3 = b2 + kstep;
            if (last && has_next) S.a_ready(nxt);
            if constexpr (SP2) {
            PG8_LDB(B0, 0, 0); PG8_LDB(B1, 0, 1); PG8_SCHED; PG8_LDA(At, 0, 0); PG8_STAGE(PG8_SA(1, 1), a1 + hstep, voffA);
            PG8_WAIT_V(8); PG8_WAIT_L(0); PG8_BAR; PG8_MMA(0, 0, At, B0); PG8_MMA(0, 1, At, B1); PG8_BAR; PG8_SCHED;
            PG8_LDA(At, 0, 1); PG8_STAGE(PG8_SB(0, 0), b2, voffB); PG8_STAGE(PG8_SB(0, 1), b2 + hstep, voffB); PG8_STAGE(PG8_SA(0, 0), a2, voffA);
            PG8_WAIT_V(8); PG8_WAIT_L(0); PG8_BAR; PG8_MMA(1, 0, At, B0); PG8_MMA(1, 1, At, B1); PG8_BAR; PG8_SCHED;
            PG8_LDB(B0, 1, 0); PG8_LDB(B1, 1, 1); PG8_SCHED; PG8_LDA(At, 1, 0); PG8_STAGE(PG8_SA(0, 1), a2 + hstep, voffA);
            PG8_WAIT_V(8); PG8_WAIT_L(0); PG8_BAR; PG8_MMA(0, 0, At, B0); PG8_MMA(0, 1, At, B1); PG8_BAR; PG8_SCHED;
            PG8_LDA(At, 1, 1); PG8_STAGE(PG8_SB(1, 0), b3, voffB); PG8_STAGE(PG8_SB(1, 1), b3 + hstep, voffB); PG8_STAGE(PG8_SA(1, 0), a3, voffA);
            PG8_WAIT_V(8); PG8_WAIT_L(0); PG8_BAR; PG8_MMA(1, 0, At, B0); PG8_MMA(1, 1, At, B1); PG8_BAR; PG8_SCHED;
            } else {
            PG8_LDB(B0, 0, 0); PG8_SCHED; PG8_LDA(At, 0, 0); PG8_STAGE(PG8_SA(1, 1), a1 + hstep, voffA);
            PG8_WAIT_L(8); PG8_BAR; PG8_WAIT_L(0); PG8_MMA(0, 0, At, B0); PG8_BAR; PG8_SCHED;
            PG8_LDB(B1, 0, 1); PG8_STAGE(PG8_SB(0, 0), b2, voffB);
            PG8_BAR; PG8_WAIT_L(0); PG8_MMA(0, 1, At, B1); PG8_BAR;
            PG8_LDA(At, 0, 1); PG8_STAGE(PG8_SA(0, 0), a2, voffA);
            PG8_BAR; PG8_WAIT_L(0); PG8_MMA(1, 0, At, B0); PG8_BAR; PG8_SCHED;
            PG8_STAGE(PG8_SB(0, 1), b2 + hstep, voffB);
            PG8_WAIT_V(6); PG8_BAR; PG8_MMA(1, 1, At, B1); PG8_BAR;
            PG8_LDB(B0, 1, 0); PG8_SCHED; PG8_LDA(At, 1, 0); PG8_STAGE(PG8_SA(0, 1), a2 + hstep, voffA);
            PG8_WAIT_L(8); PG8_BAR; PG8_WAIT_L(0); PG8_MMA(0, 0, At, B0); PG8_BAR; PG8_SCHED;
            PG8_LDB(B1, 1, 1); PG8_STAGE(PG8_SB(1, 0), b3, voffB);
            PG8_BAR; PG8_WAIT_L(0); PG8_MMA(0, 1, At, B1); PG8_BAR;
            PG8_LDA(At, 1, 1); PG8_STAGE(PG8_SA(1, 0), a3, voffA);
            PG8_BAR; PG8_WAIT_L(0); PG8_MMA(1, 0, At, B0); PG8_BAR; PG8_SCHED;
            PG8_STAGE(PG8_SB(1, 1), b3 + hstep, voffB);
            PG8_WAIT_V(6); PG8_BAR; PG8_MMA(1, 1, At, B1); PG8_BAR;
            }
        }
        if constexpr (ALIGN_EPI) { if (wr == 0) PG8_BAR; }
        if constexpr (!Epi::AFTER_DRAIN) { E(acc, cur, wr, wc, fr, fq); S.done(cur); }
        if (!has_next) break;
#pragma unroll
        for (int a = 0; a < 2; ++a)
#pragma unroll
            for (int b = 0; b < 2; ++b)
#pragma unroll
                for (int m = 0; m < 4; ++m)
#pragma unroll
                    for (int n = 0; n < 2; ++n) acc[a][b][m][n] = (f32x4){0.f, 0.f, 0.f, 0.f};
        cur = nxt; cA = nA; cB = nB; ++ui;
        if constexpr (ALIGN_EPI) { if (wr == 1) PG8_BAR; }
    }
    PG8_WAIT_V(0);
    if constexpr (!ALIGN_EPI) { if (wr == 0) PG8_BAR; }
    PG8_BAR;
    if constexpr (Epi::AFTER_DRAIN) { E.fused(acc, cur, wr, wc, fr, fq, lds, wid, lane); S.done(cur); }
#undef PG8_SA
#undef PG8_SB
#undef PG8_STAGE
#undef PG8_LDA
#undef PG8_LDB
#undef PG8_MMA
#undef PG8_WAIT_V
#undef PG8_WAIT_L
#undef PG8_BAR
#undef PG8_SCHED
}
}
#define GAS __attribute__((address_space(1)))
#define LAS __attribute__((address_space(3)))
typedef unsigned short bf16;
typedef unsigned v4u __attribute__((ext_vector_type(4)));
typedef float f32x4 __attribute__((ext_vector_type(4)));
typedef short bf16x8 __attribute__((ext_vector_type(8)));
typedef GAS unsigned gu32;
typedef GAS unsigned long long gu64;
#define RLX_AGENT __ATOMIC_RELAXED, __HIP_MEMORY_SCOPE_AGENT
#define LDS_WAIT() asm volatile("s_waitcnt lgkmcnt(0)" ::: "memory")
#define VM_WAIT() asm volatile("s_waitcnt vmcnt(0)" ::: "memory")
__device__ __forceinline__ unsigned long long rt() { return __builtin_amdgcn_s_memrealtime(); }
__device__ __forceinline__ unsigned f2bf(float f) { unsigned u = __builtin_bit_cast(unsigned, f); return (u + 0x7fffu + ((u >> 16) & 1u)) >> 16; }
__device__ __forceinline__ unsigned pk2(float lo, float hi) { return f2bf(lo) | (f2bf(hi) << 16); }
#define XB_TMO      128
#define XB_XCNT(j)  (256  + 64 * (j))
#define XB_XSUB(j)  (1280 + 64 * (j))
#define XB_XGEN(j)  (2304 + 64 * (j))
#define XB_TOP      3328
#define XB_TOPGEN   3392
#define XCD_BAR_WORDS 3456
#define XB_SPIN_CAP (1u << 18)

__device__ __forceinline__ unsigned xb_ld(unsigned* p)              { return __hip_atomic_load(p, __ATOMIC_RELAXED, __HIP_MEMORY_SCOPE_AGENT); }
__device__ __forceinline__ unsigned xb_add(unsigned* p, unsigned v) { return __hip_atomic_fetch_add(p, v, __ATOMIC_RELAXED, __HIP_MEMORY_SCOPE_AGENT); }
__device__ __forceinline__ unsigned xb_xcc_id() { return (unsigned)__builtin_amdgcn_s_getreg((3 << 11) | 20) & 0xFu; }
#define XB_SPIN(cond, bar) do { unsigned _sp = 0; while (cond) { __builtin_amdgcn_s_sleep(1); \
    if ((++_sp & 255u) == 0u) { if (xb_ld(&(bar)[XB_TMO])) break; if (_sp > XB_SPIN_CAP) { atomicAdd(&(bar)[XB_TMO], 1u); break; } } } } while (0)

struct XcdBarrier {
    unsigned* bar; unsigned x;
    volatile LAS unsigned* st;
};

__device__ __forceinline__ XcdBarrier xcd_barrier_post(unsigned* bar, volatile LAS unsigned* st) {
    XcdBarrier b; b.bar = bar; b.x = xb_xcc_id(); b.st = st;
    if (threadIdx.x == 0) (void)xb_add(&bar[XB_XCNT(b.x)], 1u);
    return b;
}
__device__ __forceinline__ void xcd_barrier_complete(unsigned* bar, unsigned x, unsigned& nloc, unsigned& nx) {
    const unsigned G = gridDim.x * gridDim.y * gridDim.z;
    unsigned sum, cnt, mine, sp = 0u;
    for (;;) {
        sum = 0u; cnt = 0u; mine = 0u;
#pragma unroll
        for (unsigned j = 0; j < 16; ++j) { const unsigned c = xb_ld(&bar[XB_XCNT(j)]); sum += c; cnt += (c > 0u) ? 1u : 0u; mine = (j == x) ? c : mine; }
        if (sum == G) break;
        __builtin_amdgcn_s_sleep(1);
        if ((++sp & 255u) == 0u) { if (xb_ld(&bar[XB_TMO])) break; if (sp > XB_SPIN_CAP) { atomicAdd(&bar[XB_TMO], 1u); break; } }
    }
    nloc = mine > 0u ? mine : 1u; nx = cnt > 0u ? cnt : 1u;
}

__device__ __forceinline__ void xcd_barrier(const XcdBarrier& b) {
    asm volatile("s_waitcnt vmcnt(0)" ::: "memory");
    __syncthreads();
    if (threadIdx.x == 0) {
        unsigned* bar = b.bar;
        __builtin_amdgcn_s_waitcnt(0);
        unsigned nloc = b.st[0], nx = b.st[1];
        if (nloc == 0u) { xcd_barrier_complete(bar, b.x, nloc, nx); b.st[0] = nloc; b.st[1] = nx; }
        const unsigned old = xb_add(&bar[XB_XSUB(b.x)], 1u);
        const unsigned gen = old / nloc;
        if (old + 1u == (gen + 1u) * nloc) {
            __builtin_amdgcn_fence(__ATOMIC_RELEASE, "agent");
            asm volatile("s_waitcnt vmcnt(0)" ::: "memory");
            const unsigned og = xb_add(&bar[XB_TOP], 1u);
            const unsigned tg = og / nx;
            if (og + 1u == (tg + 1u) * nx) xb_add(&bar[XB_TOPGEN], 1u);
            else XB_SPIN(xb_ld(&bar[XB_TOPGEN]) == tg, bar);
            __builtin_amdgcn_fence(__ATOMIC_ACQUIRE, "agent");
            xb_add(&bar[XB_XGEN(b.x)], 1u);
            asm volatile("s_waitcnt vmcnt(0)" ::: "memory");
        } else {
            XB_SPIN(xb_ld(&bar[XB_XGEN(b.x)]) == gen, bar);
            __builtin_amdgcn_fence(__ATOMIC_ACQUIRE, "agent");
            asm volatile("s_waitcnt vmcnt(0)" ::: "memory");
        }
    }
    __syncthreads();
}
constexpr int NB = 4, S = 8192, D = 1024, NH = 16, HD = 64, FF = 4096, NMETA = 16, DEPTH = 4;
constexpr int M = NB * S;
constexpr float EPS = 1e-6f;
constexpr float QSCALE = 0.125f * 1.4426950408889634f;
constexpr float SB_THRESH = 160.f;
constexpr int NWAVES = 8;

constexpr size_t MiB = 1u << 20, KiB = 1u << 10;
constexpr size_t WS_CTL = 0, CTL_ZERO_BYTES = 64 * KiB;
constexpr size_t WS_META = 1 * MiB;
constexpr size_t MO_HM = 0, MO_HMB = 64 * KiB, MO_BM = 96 * KiB, MO_UM = 128 * KiB, MO_VM = 160 * KiB, MO_YM = 192 * KiB, MO_FM = 224 * KiB, MO_KM = 352 * KiB, MO_VTM = 384 * KiB;
constexpr size_t WS_WIN = 2 * MiB, WS_WOUT = 14 * MiB, WS_WQK = 18 * MiB, WS_WV = 22 * MiB, WS_WQ3 = 24 * MiB, WS_WO = 26 * MiB, WS_W1 = 30 * MiB, WS_W2 = 62 * MiB;
constexpr size_t WS_HB = 96 * MiB, WS_K = 160 * MiB, WS_VT = 224 * MiB, WS_R0 = 288 * MiB, WS_R1 = 352 * MiB, WS_R2 = 416 * MiB, WS_END = 480 * MiB;
constexpr int CW_BAR = 4096;
static_assert((CW_BAR + 3456) * 4 <= (int)CTL_ZERO_BYTES, "barrier words inside the memset region");

constexpr int RING_BYTES = 131072, MISC_OFF = RING_BYTES + 320, LDS_BYTES = 147456;

typedef float f32x16 __attribute__((ext_vector_type(16)));
typedef unsigned u32x2 __attribute__((ext_vector_type(2)));

__device__ __forceinline__ float wave_sum(float v) {
#pragma unroll
    for (int o = 1; o < 64; o <<= 1) v += __shfl_xor(v, o);
    return v;
}
__device__ __forceinline__ float bflo(unsigned w) { return __uint_as_float(w << 16); }
__device__ __forceinline__ float bfhi(unsigned w) { return __uint_as_float(w & 0xffff0000u); }
__device__ __forceinline__ unsigned cvtpk(float lo, float hi) { return pg8::cvt_pk_bf16(lo, hi); }
__device__ __forceinline__ void unpack8(const v4u w, float (&f)[8]) { f[0] = bflo(w.x); f[1] = bfhi(w.x); f[2] = bflo(w.y); f[3] = bfhi(w.y); f[4] = bflo(w.z); f[5] = bfhi(w.z); f[6] = bflo(w.w); f[7] = bfhi(w.w); }

__device__ __forceinline__ void cvt_item(const float* W, int K, int N, bf16* WT, const float* gain, float scale, int mode, LAS float* scr, int item, int lane) {
    const int nblk = N / 32, kb = item / nblk, nb = item % nblk, k0 = 64 * kb, n0 = 32 * nb;
#pragma unroll 8
    for (int i = 0; i < 32; ++i) { const int kk = 2 * i + (lane >> 5); const float gs = gain ? gain[k0 + kk] * scale : scale; scr[kk * 33 + (lane & 31)] = W[(size_t)(k0 + kk) * N + n0 + (lane & 31)] * gs; }
    LDS_WAIT(); asm volatile("" ::: "memory");
    int nd0 = n0;
    if (mode == 1 && n0 >= 1024) { const int o = (n0 - 1024) & 1023; nd0 = 1024 + 256 * (o >> 7) + (n0 >= 2048 ? 128 : 0) + (o & 127); }
    const int c = lane & 7;
#pragma unroll
    for (int j = 0; j < 4; ++j) { const int n = (lane >> 3) + 8 * j; const LAS float* s = scr + (8 * c) * 33 + n;
        v4u o; o.x = pk2(s[0 * 33], s[1 * 33]); o.y = pk2(s[2 * 33], s[3 * 33]); o.z = pk2(s[4 * 33], s[5 * 33]); o.w = pk2(s[6 * 33], s[7 * 33]);
        *(GAS v4u*)(WT + (size_t)(nd0 + n) * K + k0 + 8 * c) = o; }
    LDS_WAIT(); asm volatile("" ::: "memory");
}
__device__ __forceinline__ void norm_row_to_bf16(const float* xrow, bf16* orow, int lane) {
    const f32x4* xr = (const f32x4*)xrow + lane;
    f32x4 v[4]; float s = 0.f;
#pragma unroll
    for (int j = 0; j < 4; ++j) { v[j] = xr[64 * j]; s += (v[j].x * v[j].x + v[j].y * v[j].y) + (v[j].z * v[j].z + v[j].w * v[j].w); }
    const float r = 1.f / sqrtf(wave_sum(s) * (1.f / D) + EPS);
    u32x2* o8 = (u32x2*)orow + lane;
#pragma unroll
    for (int j = 0; j < 4; ++j) { u32x2 w; w.x = cvtpk(v[j].x * r, v[j].y * r); w.y = cvtpk(v[j].z * r, v[j].w * r); o8[64 * j] = w; }
}
__device__ __forceinline__ void nr_row(const bf16* yrow, const float* hin, float* hout, bf16* hbrow, const float* gain, int lane) {
    f32x4 hv[4], yv[4]; float ss = 0.f;
#pragma unroll
    for (int j = 0; j < 4; ++j) { const u32x2 w = *((const u32x2*)yrow + lane + 64 * j); yv[j] = (f32x4){bflo(w.x), bfhi(w.x), bflo(w.y), bfhi(w.y)};
        hv[j] = *((const f32x4*)hin + lane + 64 * j); ss += (yv[j].x * yv[j].x + yv[j].y * yv[j].y) + (yv[j].z * yv[j].z + yv[j].w * yv[j].w); }
    const float ry = 1.f / sqrtf(wave_sum(ss) * (1.f / D) + EPS);
    float s2 = 0.f;
#pragma unroll
    for (int j = 0; j < 4; ++j) { const f32x4 g4 = *((const f32x4*)gain + lane + 64 * j); hv[j] = hv[j] + (yv[j] * ry) * g4; *((f32x4*)hout + lane + 64 * j) = hv[j];
        s2 += (hv[j].x * hv[j].x + hv[j].y * hv[j].y) + (hv[j].z * hv[j].z + hv[j].w * hv[j].w); }
    const float rh = 1.f / sqrtf(wave_sum(s2) * (1.f / D) + EPS);
#pragma unroll
    for (int j = 0; j < 4; ++j) { u32x2 w; w.x = cvtpk(hv[j].x * rh, hv[j].y * rh); w.y = cvtpk(hv[j].z * rh, hv[j].w * rh); *((u32x2*)hbrow + lane + 64 * j) = w; }
}
__device__ __forceinline__ f32x4 meta_tile(const bf16* A, const bf16* Wt, int K, int n0, LAS float* red, int wave, int lane) {
    const int kw = K >> 3, kbeg = wave * kw;
    const bf16* ap = A + (size_t)(lane & 15) * K + kbeg + 8 * (lane >> 4);
    const bf16* bp = Wt + (size_t)(n0 + (lane & 15)) * K + kbeg + 8 * (lane >> 4);
    f32x4 acc = (f32x4){0.f, 0.f, 0.f, 0.f};
#pragma unroll 4
    for (int k = 0; k < kw; k += 32) { const bf16x8 a = *(const bf16x8*)(ap + k); const bf16x8 b = *(const bf16x8*)(bp + k); acc = __builtin_amdgcn_mfma_f32_16x16x32_bf16(a, b, acc, 0, 0, 0); }
    *((LAS f32x4*)red + wave * 64 + lane) = acc;
    __syncthreads();
    if (wave == 0) {
#pragma unroll
        for (int w = 1; w < 8; ++w) acc = acc + *((LAS f32x4*)red + w * 64 + lane);
    }
    __syncthreads();
    return acc;
}

__device__ __forceinline__ void attn_unit(const bf16* Q, const bf16* Kb, const bf16* Vt, const bf16* Km, const bf16* Vtm, bf16* O, int b, int hh, int qblk, int lane) {
    const int q = lane & 31, h = lane >> 5;
    const int pi = (q & 0x13) | (((q >> 2) & 1) << 3) | (((q >> 3) & 1) << 2);
    const size_t rowbase = (size_t)b * S; const int i0 = qblk * 32;
    bf16x8 qf[4];
    { const bf16* qp = Q + (rowbase + i0 + q) * D + hh * HD + 8 * h;
#pragma unroll
      for (int s = 0; s < 4; ++s) qf[s] = *(const bf16x8*)(qp + 16 * s); }
    const bf16* kbase = Kb + (rowbase + pi) * D + hh * HD + 8 * h;
    const bf16* vbase = Vt + (size_t)(hh * HD + q) * M + rowbase + 8 * h;
    const bf16* kmp = Km + (size_t)(pi & 15) * D + hh * HD + 8 * h;
    const bf16* vmp = Vtm + (size_t)(hh * HD + q) * NMETA + 8 * h;
    f32x16 o0, o1;
#pragma unroll
    for (int r = 0; r < 16; ++r) { o0[r] = 0.f; o1[r] = 0.f; }
    float R = 0.f;
    bf16x8 ck[4], cv[4], nk[4], nv[4];
    const bf16x8 zero8 = (bf16x8){0, 0, 0, 0, 0, 0, 0, 0};
#define LOADKV(kd, vd, j) do { if ((j) >= 0) { const bf16* kp_ = kbase + (size_t)(j) * 32 * D; const bf16* vp_ = vbase + (size_t)(j) * 32; \
        _Pragma("unroll") for (int s = 0; s < 4; ++s) kd[s] = *(const bf16x8*)(kp_ + 16 * s); \
        vd[0] = *(const bf16x8*)(vp_); vd[1] = *(const bf16x8*)(vp_ + 16); vd[2] = *(const bf16x8*)(vp_ + (size_t)32 * M); vd[3] = *(const bf16x8*)(vp_ + (size_t)32 * M + 16); } \
      else { _Pragma("unroll") for (int s = 0; s < 4; ++s) kd[s] = *(const bf16x8*)(kmp + 16 * s); \
        vd[0] = *(const bf16x8*)(vmp); vd[1] = zero8; vd[2] = *(const bf16x8*)(vmp + 32 * NMETA); vd[3] = zero8; } } while (0)
    LOADKV(ck, cv, qblk);
    int jb = qblk;
    for (;;) {
        const int jn = jb - 1;
        if (jn >= -1) LOADKV(nk, nv, jn);
        f32x16 st;
#pragma unroll
        for (int r = 0; r < 16; ++r) st[r] = 0.f;
#pragma unroll
        for (int s = 0; s < 4; ++s) st = __builtin_amdgcn_mfma_f32_32x32x16_bf16(ck[s], qf[s], st, 0, 0, 0);
        const bool full = (jb >= 0) && (jb < qblk); const bool metab = jb < 0;
        float sp[16], zz[16];
#pragma unroll
        for (int r = 0; r < 16; ++r) { const int kk = (r & 7) + 8 * h + 16 * (r >> 3); const bool vis = full || (metab ? (kk < NMETA) : (kk < q));
            const float z = st[r]; const float e = __builtin_amdgcn_exp2f(-fabsf(z)); const float l = __builtin_amdgcn_logf(1.f + e); const float s_ = fmaxf(z, 0.f) + l;
            sp[r] = vis ? s_ : 0.f; zz[r] = vis ? z : -1e30f; }
        float sA[8], sB[8];
        sA[7] = sp[7]; sB[7] = sp[15];
#pragma unroll
        for (int j = 6; j >= 0; --j) { sA[j] = sp[j] + sA[j + 1]; sB[j] = sp[8 + j] + sB[j + 1]; }
        const float TA = sA[0], TB = sB[0];
        const float TAp = __shfl_xor(TA, 32), TBp = __shfl_xor(TB, 32);
        const float baseA = ((h == 0) ? (TAp + TB + TBp) : (TBp + TB)) + R;
        const float baseB = ((h == 0) ? TBp : 0.f) + R;
        float a[16];
#pragma unroll
        for (int j = 0; j < 8; ++j) { a[j] = __builtin_amdgcn_exp2f(zz[j] - (sA[j] + baseA)); a[8 + j] = __builtin_amdgcn_exp2f(zz[8 + j] - (sB[j] + baseB)); }
        R += (TA + TAp) + (TB + TBp);
        v4u p0w, p1w;
        p0w.x = cvtpk(a[0], a[1]); p0w.y = cvtpk(a[2], a[3]); p0w.z = cvtpk(a[4], a[5]); p0w.w = cvtpk(a[6], a[7]);
        p1w.x = cvtpk(a[8], a[9]); p1w.y = cvtpk(a[10], a[11]); p1w.z = cvtpk(a[12], a[13]); p1w.w = cvtpk(a[14], a[15]);
        const bf16x8 p0 = __builtin_bit_cast(bf16x8, p0w), p1 = __builtin_bit_cast(bf16x8, p1w);
        o0 = __builtin_amdgcn_mfma_f32_32x32x16_bf16(cv[0], p0, o0, 0, 0, 0); o0 = __builtin_amdgcn_mfma_f32_32x32x16_bf16(cv[1], p1, o0, 0, 0, 0);
        o1 = __builtin_amdgcn_mfma_f32_32x32x16_bf16(cv[2], p0, o1, 0, 0, 0); o1 = __builtin_amdgcn_mfma_f32_32x32x16_bf16(cv[3], p1, o1, 0, 0, 0);
        if (jn < -1) break;
        if (__all(R > SB_THRESH)) break;
#pragma unroll
        for (int s = 0; s < 4; ++s) { ck[s] = nk[s]; cv[s] = nv[s]; }
        jb = jn;
    }
#undef LOADKV
    bf16* op = O + (rowbase + i0 + q) * D + hh * HD + 4 * h;
#pragma unroll
    for (int g = 0; g < 4; ++g) { u32x2 w0, w1; w0.x = cvtpk(o0[4 * g], o0[4 * g + 1]); w0.y = cvtpk(o0[4 * g + 2], o0[4 * g + 3]); w1.x = cvtpk(o1[4 * g], o1[4 * g + 1]); w1.y = cvtpk(o1[4 * g + 2], o1[4 * g + 3]);
        *(u32x2*)(op + 8 * g) = w0; *(u32x2*)(op + 32 + 8 * g) = w1; }
}

struct Args { const float* in[13]; float* out; unsigned char* ws; };
__global__ void __launch_bounds__(NWAVES * 64, 2) yoco_fwd(Args args) {
    extern __shared__ __attribute__((aligned(16))) unsigned char lds_raw[];
    LAS unsigned char* lds = (LAS unsigned char*)lds_raw;
    volatile LAS unsigned* MISC = (volatile LAS unsigned*)(lds + MISC_OFF);
    const int G = gridDim.x, bx = blockIdx.x;
    const int vcu = (G % 8 == 0) ? (bx % 8) * (G / 8) + bx / 8 : bx;
    const int NGW = G * NWAVES;
    const float* x = args.in[0]; const float* meta_tokens = args.in[1]; const float* ng = args.in[2]; const float* conv_in = args.in[3]; const float* conv_w = args.in[4];
    const float* conv_out = args.in[5]; const float* kv_norm = args.in[6]; const float* w_k = args.in[7]; const float* w_v = args.in[8]; const float* w_q = args.in[9];
    const float* w_o = args.in[10]; const float* mlp_w1 = args.in[11]; const float* mlp_w2 = args.in[12];
    float* out = args.out;
    LAS float* red = (LAS float*)lds;
#define PHASE_BEGIN \
    int tid = threadIdx.x; asm volatile("" : "+v"(tid)); \
    const int lane = tid & 63, wave = __builtin_amdgcn_readfirstlane(tid >> 6); \
    GAS unsigned char* wsg_ = (GAS unsigned char*)args.ws; asm volatile("" : "+s"(wsg_)); unsigned char* ws = (unsigned char*)wsg_; \
    const int gw = vcu * NWAVES + wave; (void)gw; (void)lane;
#define Win_t ((bf16*)(ws + WS_WIN))
#define Wout_t ((bf16*)(ws + WS_WOUT))
#define Wqk_t ((bf16*)(ws + WS_WQK))
#define Wv_t ((bf16*)(ws + WS_WV))
#define Wq3_t ((bf16*)(ws + WS_WQ3))
#define Wo_t ((bf16*)(ws + WS_WO))
#define W1_t ((bf16*)(ws + WS_W1))
#define W2_t ((bf16*)(ws + WS_W2))
#define HB ((bf16*)(ws + WS_HB))
#define KB ((bf16*)(ws + WS_K))
#define VT ((bf16*)(ws + WS_VT))
#define R0 ((bf16*)(ws + WS_R0))
#define R1 ((bf16*)(ws + WS_R1))
#define R2 ((bf16*)(ws + WS_R2))
#define hm ((float*)(ws + WS_META + MO_HM))
#define hmb ((bf16*)(ws + WS_META + MO_HMB))
#define bm ((bf16*)(ws + WS_META + MO_BM))
#define um ((bf16*)(ws + WS_META + MO_UM))
#define vm ((bf16*)(ws + WS_META + MO_VM))
#define ym ((bf16*)(ws + WS_META + MO_YM))
#define fm ((bf16*)(ws + WS_META + MO_FM))
#define km ((bf16*)(ws + WS_META + MO_KM))
#define vtm ((bf16*)(ws + WS_META + MO_VTM))

    if (threadIdx.x < 32) MISC[threadIdx.x] = 0u;
    __syncthreads();
    XcdBarrier bar = xcd_barrier_post((unsigned*)(args.ws + WS_CTL) + CW_BAR, MISC + 8);
#define GRID_BAR() do { XcdBarrier b_ = bar; GAS unsigned* bg_ = (GAS unsigned*)b_.bar; asm volatile("" : "+s"(bg_)); b_.bar = (unsigned*)bg_; xcd_barrier(b_); } while (0)

    {
        PHASE_BEGIN
        LAS float* scr = (LAS float*)(lds + wave * 16384);
        constexpr int NITEMS = 23552;
        for (int it = gw; it < NITEMS; it += NGW) {
            int r = it;
            if (r < 3072) { const int l = r / 1536; cvt_item(conv_in + (size_t)l * D * 3 * D, D, 3 * D, Win_t + (size_t)l * 3 * D * D, ng + (size_t)(l * 4 + 0) * D, 1.f, 1, scr, r % 1536, lane); continue; } r -= 3072;
            if (r < 1024) { const int l = r / 512; cvt_item(conv_out + (size_t)l * D * D, D, D, Wout_t + (size_t)l * D * D, nullptr, 1.f, 0, scr, r % 512, lane); continue; } r -= 1024;
            if (r < 512) { cvt_item(w_q, D, D, Wqk_t, ng + (size_t)(2 * 4 + 0) * D, QSCALE, 0, scr, r, lane); continue; } r -= 512;
            if (r < 512) { cvt_item(w_k, D, D, Wqk_t + (size_t)D * D, kv_norm, 1.f, 0, scr, r, lane); continue; } r -= 512;
            if (r < 512) { cvt_item(w_v, D, D, Wv_t, kv_norm, 1.f, 0, scr, r, lane); continue; } r -= 512;
            if (r < 512) { cvt_item(w_q + (size_t)D * D, D, D, Wq3_t, ng + (size_t)(3 * 4 + 0) * D, QSCALE, 0, scr, r, lane); continue; } r -= 512;
            if (r < 1024) { const int l = r / 512; cvt_item(w_o + (size_t)l * D * D, D, D, Wo_t + (size_t)l * D * D, nullptr, 1.f, 0, scr, r % 512, lane); continue; } r -= 1024;
            if (r < 8192) { const int l = r / 2048; cvt_item(mlp_w1 + (size_t)l * D * FF, D, FF, W1_t + (size_t)l * FF * D, ng + (size_t)(l * 4 + 2) * D, 1.f, 0, scr, r % 2048, lane); continue; } r -= 8192;
            { const int l = r / 2048; cvt_item(mlp_w2 + (size_t)l * FF * D, FF, D, W2_t + (size_t)l * D * FF, nullptr, 1.f, 0, scr, r % 2048, lane); }
        }
        for (int m = gw; m < M + NMETA; m += NGW) {
            if (m < M) norm_row_to_bf16(x + (size_t)m * D, HB + (size_t)m * D, lane);
            else norm_row_to_bf16(meta_tokens + (size_t)(m - M) * D, hmb + (size_t)(m - M) * D, lane);
        }
    }
    GRID_BAR();

#pragma clang loop unroll(disable)
    for (int layer = 0; layer < DEPTH; ++layer) {
        const float* gl = ng + (size_t)layer * 4 * D;
        const bool has_meta = layer < 2;
        if (layer < 2) {
            {
                PHASE_BEGIN
                const bf16* W = Win_t + (size_t)layer * 3 * D * D;
                for (int t = bx; t < 128; t += G) {
                    if (t < 64) { const f32x4 acc = meta_tile(hmb, W, D, 16 * t, red, wave, lane);
                        if (wave == 0) {
#pragma unroll
                            for (int i = 0; i < 4; ++i) bm[(4 * (lane >> 4) + i) * D + 16 * t + (lane & 15)] = (bf16)f2bf(acc[i]); } }
                    else { const int tt = t - 64, n0c = 1024 + 256 * (tt >> 3) + 16 * (tt & 7);
                        const f32x4 ac = meta_tile(hmb, W, D, n0c, red, wave, lane); const f32x4 ax = meta_tile(hmb, W, D, n0c + 128, red, wave, lane);
                        if (wave == 0) {
#pragma unroll
                            for (int i = 0; i < 4; ++i) um[(4 * (lane >> 4) + i) * D + 128 * (tt >> 3) + 16 * (tt & 7) + (lane & 15)] = (bf16)f2bf(ac[i] * ax[i]); } }
                }
                __syncthreads();
                pg8::Gemm g{HB, W, M, 3 * D, D}; pg8::StaticOrder So; So.init(M, 3 * D, G, bx);
                pg8::EpiConvIn E{R0, R1};
                pg8::gemm_phase<pg8::EpiConvIn, pg8::StaticOrder, true, true>(lds, g, So, E);
            }
            GRID_BAR();
            {
                PHASE_BEGIN
                const int chunk = tid & 127, rg = tid >> 7, col0 = chunk * 8;
                const float* cw = conv_w + (size_t)layer * 3 * D + col0;
                float w0[8], w1[8], w2[8];
#pragma unroll
                for (int e = 0; e < 8; ++e) { w0[e] = cw[e]; w1[e] = cw[D + e]; w2[e] = cw[2 * D + e]; }
                for (int cb = vcu; cb < M / 128; cb += G) {
                    const int r0 = cb * 128 + rg * 32;
                    v4u up2, up1;
                    if ((r0 & (S - 1)) == 0) { up2 = *(const v4u*)(um + 14 * D + col0); up1 = *(const v4u*)(um + 15 * D + col0); }
                    else { up2 = *(const v4u*)(R1 + (size_t)(r0 - 2) * D + col0); up1 = *(const v4u*)(R1 + (size_t)(r0 - 1) * D + col0); }
                    float p2[8], p1[8]; unpack8(up2, p2); unpack8(up1, p1);
#pragma unroll 4
                    for (int i = 0; i < 32; ++i) {
                        const size_t off = (size_t)(r0 + i) * D + col0;
                        const v4u uw = *(const v4u*)(R1 + off); const v4u bw = *(const v4u*)(R0 + off);
                        float u[8], bb[8], v[8]; unpack8(uw, u); unpack8(bw, bb);
#pragma unroll
                        for (int e = 0; e < 8; ++e) { v[e] = bb[e] * (w0[e] * p2[e] + w1[e] * p1[e] + w2[e] * u[e]); p2[e] = p1[e]; p1[e] = u[e]; }
                        v4u o; o.x = cvtpk(v[0], v[1]); o.y = cvtpk(v[2], v[3]); o.z = cvtpk(v[4], v[5]); o.w = cvtpk(v[6], v[7]);
                        *(v4u*)(R2 + off) = o;
                    }
                }
                const int gt = vcu * (NWAVES * 64) + tid;
                if (gt < NMETA * 128) {
                    const int t = gt >> 7, c0 = (gt & 127) * 8; const float* cwm = conv_w + (size_t)layer * 3 * D + c0;
                    float u0[8], u1[8], u2[8], bb[8];
                    unpack8(*(const v4u*)(um + t * D + c0), u2); unpack8(*(const v4u*)(bm + t * D + c0), bb);
                    unpack8(*(const v4u*)(um + (t >= 1 ? t - 1 : 0) * D + c0), u1); unpack8(*(const v4u*)(um + (t >= 2 ? t - 2 : 0) * D + c0), u0);
                    const float f1 = t >= 1 ? 1.f : 0.f, f0 = t >= 2 ? 1.f : 0.f;
                    float v[8];
#pragma unroll
                    for (int e = 0; e < 8; ++e) v[e] = bb[e] * (cwm[e] * (u0[e] * f0) + cwm[D + e] * (u1[e] * f1) + cwm[2 * D + e] * u2[e]);
                    v4u o; o.x = cvtpk(v[0], v[1]); o.y = cvtpk(v[2], v[3]); o.z = cvtpk(v[4], v[5]); o.w = cvtpk(v[6], v[7]);
                    *(v4u*)(vm + t * D + c0) = o;
                }
            }
            GRID_BAR();
        } else {
            if (layer == 2) {
                PHASE_BEGIN
                for (int t = bx; t < 128; t += G) {
                    if (t < 64) { const f32x4 acc = meta_tile(hmb, Wqk_t + (size_t)D * D, D, 16 * t, red, wave, lane);
                        if (wave == 0) {
#pragma unroll
                            for (int i = 0; i < 4; ++i) km[(4 * (lane >> 4) + i) * D + 16 * t + (lane & 15)] = (bf16)f2bf(acc[i]); } }
                    else { const int tt = t - 64; const f32x4 acc = meta_tile(hmb, Wv_t, D, 16 * tt, red, wave, lane);
                        if (wave == 0) {
#pragma unroll
                            for (int i = 0; i < 4; ++i) vtm[(16 * tt + (lane & 15)) * NMETA + 4 * (lane >> 4) + i] = (bf16)f2bf(acc[i]); } }
                }
                __syncthreads();
                { pg8::Gemm g{HB, Wqk_t, M, 2 * D, D}; pg8::StaticOrder So; So.init(M, 2 * D, G, bx);
                  pg8::EpiPlain E{R1, D, D, ((long)WS_K - (long)WS_R1) / 2};
                  pg8::gemm_phase<pg8::EpiPlain, pg8::StaticOrder, true, true>(lds, g, So, E); }
                __syncthreads();
                { pg8::Gemm g{Wv_t, HB, D, M, D}; pg8::StaticOrder So; So.init(D, M, G, bx);
                  pg8::EpiPlain E{VT, M, 0, 0};
                  pg8::gemm_phase<pg8::EpiPlain, pg8::StaticOrder, true, true>(lds, g, So, E); }
            } else {
                PHASE_BEGIN
                pg8::Gemm g{HB, Wq3_t, M, D, D}; pg8::StaticOrder So; So.init(M, D, G, bx);
                pg8::EpiPlain E{R1, D, 0, 0};
                pg8::gemm_phase<pg8::EpiPlain, pg8::StaticOrder, true, true>(lds, g, So, E);
            }
            GRID_BAR();
            { PHASE_BEGIN
            for (int id = gw; id < NB * NH * (S / 32); id += NGW) {
                const int bh = id >> 8, qblk = id & 255;
                attn_unit(R1, KB, VT, km, vtm, R1, bh >> 4, bh & 15, qblk, lane);
            } }
            GRID_BAR();
        }
        {
            PHASE_BEGIN
            const bf16* Wm = (layer < 2) ? (Wout_t + (size_t)layer * D * D) : (Wo_t + (size_t)(layer - 2) * D * D);
            const bf16* Am = (layer < 2) ? R2 : R1;
            if (has_meta) {
                for (int t = bx; t < 64; t += G) { const f32x4 acc = meta_tile(vm, Wm, D, 16 * t, red, wave, lane);
                    if (wave == 0) {
#pragma unroll
                        for (int i = 0; i < 4; ++i) ym[(4 * (lane >> 4) + i) * D + 16 * t + (lane & 15)] = (bf16)f2bf(acc[i]); } }
                __syncthreads();
            }
            pg8::Gemm g{Am, Wm, M, D, D}; pg8::StaticOrder So; So.init(M, D, G, bx);
            pg8::EpiPlain E{R0, D, 0, 0};
            pg8::gemm_phase<pg8::EpiPlain, pg8::StaticOrder, true, true>(lds, g, So, E);
        }
        GRID_BAR();
        {
            PHASE_BEGIN
            const float* hin = (layer == 0) ? x : out; const float* hmin = (layer == 0) ? meta_tokens : hm;
            const int nrows = has_meta ? M + NMETA : M;
            for (int m = gw; m < nrows; m += NGW) {
                if (m < M) nr_row(R0 + (size_t)m * D, hin + (size_t)m * D, out + (size_t)m * D, HB + (size_t)m * D, gl + D, lane);
                else { const int r = m - M; nr_row(ym + (size_t)r * D, hmin + (size_t)r * D, hm + (size_t)r * D, hmb + (size_t)r * D, gl + D, lane); }
            }
        }
        GRID_BAR();
#pragma clang loop unroll(disable)
        for (int half = 0; half < 2; ++half) {
            const size_t roff = (size_t)half * (M / 2);
            {
                PHASE_BEGIN
                const bf16* W1l = W1_t + (size_t)layer * FF * D;
                if (has_meta && half == 0) {
                    for (int t = bx; t < 256; t += G) { const f32x4 acc = meta_tile(hmb, W1l, D, 16 * t, red, wave, lane);
                        if (wave == 0) {
#pragma unroll
                            for (int i = 0; i < 4; ++i) { const float a = fmaxf(acc[i], 0.f); fm[(4 * (lane >> 4) + i) * FF + 16 * t + (lane & 15)] = (bf16)f2bf(a * a); } } }
                    __syncthreads();
                }
                pg8::Gemm g{HB + roff * D, W1l, M / 2, FF, D}; pg8::StaticOrder So; So.init(M / 2, FF, G, bx);
                pg8::EpiRelu2 E{R1, FF};
                pg8::gemm_phase<pg8::EpiRelu2, pg8::StaticOrder, true, true>(lds, g, So, E);
            }
            GRID_BAR();
            {
                PHASE_BEGIN
                const bf16* W2l = W2_t + (size_t)layer * D * FF;
                if (has_meta && half == 0) {
                    for (int t = bx; t < 64; t += G) { const f32x4 acc = meta_tile(fm, W2l, FF, 16 * t, red, wave, lane);
                        if (wave == 0) {
#pragma unroll
                            for (int i = 0; i < 4; ++i) ym[(4 * (lane >> 4) + i) * D + 16 * t + (lane & 15)] = (bf16)f2bf(acc[i]); } }
                    __syncthreads();
                }
                pg8::Gemm g{R1, W2l, M / 2, D, FF}; pg8::StaticOrder So; So.init(M / 2, D, G, bx);
                pg8::EpiPlain E{R0 + roff * D, D, 0, 0};
                pg8::gemm_phase<pg8::EpiPlain, pg8::StaticOrder, true, true>(lds, g, So, E);
            }
            GRID_BAR();
        }
        {
            PHASE_BEGIN
            const int nrows = has_meta ? M + NMETA : M;
            for (int m = gw; m < nrows; m += NGW) {
                if (m < M) nr_row(R0 + (size_t)m * D, out + (size_t)m * D, out + (size_t)m * D, HB + (size_t)m * D, gl + 3 * D, lane);
                else { const int r = m - M; nr_row(ym + (size_t)r * D, hm + (size_t)r * D, hm + (size_t)r * D, hmb + (size_t)r * D, gl + 3 * D, lane); }
            }
        }
        if (layer + 1 < DEPTH) GRID_BAR();
    }
#undef GRID_BAR
#undef PHASE_BEGIN
#undef Win_t
#undef Wout_t
#undef Wqk_t
#undef Wv_t
#undef Wq3_t
#undef Wo_t
#undef W1_t
#undef W2_t
#undef HB
#undef KB
#undef VT
#undef R0
#undef R1
#undef R2
#undef hm
#undef hmb
#undef bm
#undef um
#undef vm
#undef ym
#undef fm
#undef km
#undef vtm
}

extern "C" void kernel_launch(void* const* d_in, const int* in_sizes, int n_in, void* d_out, int out_size, void* d_ws, size_t ws_size, hipStream_t stream) {
    static int grid = 0;
    if (grid == 0) {
        if (n_in != 13 || in_sizes[0] != M * D || out_size != M * D || ws_size < WS_END) { fprintf(stderr, "kernel_launch: unexpected shapes (n_in %d, in0 %d, out %d, ws %zu); nothing launched\n", n_in, n_in > 0 ? in_sizes[0] : -1, out_size, ws_size); grid = -1; return; }
        int dev = 0, cus = 0, per_cu = 0;
        if (hipGetDevice(&dev) != hipSuccess || hipDeviceGetAttribute(&cus, hipDeviceAttributeMultiprocessorCount, dev) != hipSuccess) { grid = -1; return; }
        if (hipFuncSetAttribute((const void*)yoco_fwd, hipFuncAttributeMaxDynamicSharedMemorySize, LDS_BYTES) != hipSuccess) { fprintf(stderr, "kernel_launch: hipFuncSetAttribute failed\n"); grid = -1; return; }
        if (hipOccupancyMaxActiveBlocksPerMultiprocessor(&per_cu, (const void*)yoco_fwd, NWAVES * 64, LDS_BYTES) != hipSuccess || per_cu < 1)
            fprintf(stderr, "kernel_launch: note: occupancy query reports %d workgroups per CU\n", per_cu);
        (void)hipGetLastError();
        grid = cus;
    }
    if (grid < 0) return;
    if (hipMemsetAsync((char*)d_ws + WS_CTL, 0, CTL_ZERO_BYTES, stream) != hipSuccess) return;
    Args a{};
    for (int i = 0; i < 13; ++i) a.in[i] = (const float*)d_in[i];
    a.out = (float*)d_out; a.ws = (unsigned char*)d_ws;
    hipLaunchKernelGGL(yoco_fwd, dim3(grid), dim3(NWAVES * 64), LDS_BYTES, stream, a);
}
```

```cpp
#include <hip/hip_runtime.h>
#include <cstdio>
#include <cstdint>

namespace pg8 {
#define PG8_LAS __attribute__((address_space(3)))
typedef unsigned short bf16_t;
typedef short bf16x8 __attribute__((ext_vector_type(8)));
typedef float f32x4 __attribute__((ext_vector_type(4)));
typedef unsigned u32x4 __attribute__((ext_vector_type(4)));
constexpr int BM = 256, BK = 64, HALF = 128, HTB = HALF * BK * 2  , STAGE_BYTES = 8 * HTB, NXCD = 8, WGM = 8;

__host__ __device__ __forceinline__ int lds_byte(int r, int c) { const int st = (r >> 4) * 2 + (c >> 5), rr = r & 15, cc = c & 31, ob = rr * 64 + cc * 2; return st * 1024 + (ob ^ (((ob >> 9) & 1) << 5)); }
__host__ __device__ __forceinline__ void stage_rc(int b, int& R, int& C) { const int st = b / 1024, sb = b % 1024, swz = sb ^ (((sb >> 9) & 1) << 5); R = (st >> 1) * 16 + swz / 64; C = (st & 1) * 32 + (swz % 64) / 2; }
__host__ __device__ __forceinline__ int perm32(int rho) { const int n = rho >> 4, i = rho & 15; return 8 * (i >> 2) + 4 * n + (i & 3); }

struct Unit { int pm, pn; };
struct Gemm { const bf16_t* A; const bf16_t* Bt; int M, N, K; int ablk = 0, bblk = 0; };

struct StaticOrder {
    int nM, nN, nwg, G, c;
    __host__ __device__ void init(int M, int N, int G_, int c_) { nM = M / BM; nN = N / BM; nwg = nM * nN; G = G_; c = c_; }
    __host__ __device__ bool next(int i, Unit& u) const {
        const long L = (long)i * G + c; if (L >= nwg) return false;
        int wgid = (int)L; { const int q = nwg / NXCD, r = nwg % NXCD, xcd = wgid % NXCD, off = wgid / NXCD; wgid = (xcd < r ? xcd * (q + 1) : r * (q + 1) + (xcd - r) * q) + off; }
        const int nig = WGM * nN, gid = wgid / nig, fm = gid * WGM, gsz = (nM - fm) < WGM ? (nM - fm) : WGM;
        u.pm = fm + ((wgid % nig) % gsz); u.pn = (wgid % nig) / gsz; return true;
    }
    __device__ __forceinline__ void a_ready(const Unit&) const {}
    __device__ __forceinline__ void done(const Unit&) const {}
};

__device__ __forceinline__ unsigned cvt_pk_bf16(float lo, float hi) { unsigned r; asm volatile("v_cvt_pk_bf16_f32 %0, %1, %2" : "=v"(r) : "v"(lo), "v"(hi)); return r; }
__device__ __forceinline__ u32x4 pack8(const f32x4 v0, const f32x4 v1) { u32x4 w; w.x = cvt_pk_bf16(v0[0], v0[1]); w.y = cvt_pk_bf16(v0[2], v0[3]); w.z = cvt_pk_bf16(v1[0], v1[1]); w.w = cvt_pk_bf16(v1[2], v1[3]); return w; }
struct EpiPlain {
    static constexpr bool PERM = true, AFTER_DRAIN = false, PREFETCH = false;
    bf16_t* O; int ldc; int split_cols; long split_stride; const float* rs_row; const float* rs_col;
    __device__ __forceinline__ void operator()(const f32x4 (&acc)[2][2][4][2], const Unit& u, int wr, int wc, int fr, int fq) const {
        const int row0 = u.pm * BM + wr * 64 + fr; int colt = u.pn * BM; bf16_t* base = O;
        if (split_cols) { const int t = colt / split_cols; base += (long)t * split_stride; colt -= t * split_cols; }
        const int col0 = colt + wc * 32 + 8 * fq;
        f32x4 cs[2][2];
#pragma unroll
        for (int bj = 0; bj < 2; ++bj)
#pragma unroll
            for (int n = 0; n < 2; ++n) cs[bj][n] = rs_col ? *(const f32x4*)(rs_col + u.pn * BM + wc * 32 + 8 * fq + bj * HALF + 4 * n) : (f32x4){1.f, 1.f, 1.f, 1.f};
        float srv[2][4];
#pragma unroll
        for (int ai = 0; ai < 2; ++ai)
#pragma unroll
            for (int m = 0; m < 4; ++m) srv[ai][m] = rs_row ? rs_row[row0 + ai * HALF + m * 16] : 1.f;
#pragma unroll
        for (int ai = 0; ai < 2; ++ai)
#pragma unroll
            for (int m = 0; m < 4; ++m) { const int r = row0 + ai * HALF + m * 16; bf16_t* rowp = base + (size_t)r * ldc + col0; const float sr = srv[ai][m];
#pragma unroll
                for (int bj = 0; bj < 2; ++bj) *(u32x4*)(rowp + bj * HALF) = pack8(acc[ai][bj][m][0] * (cs[bj][0] * sr), acc[ai][bj][m][1] * (cs[bj][1] * sr)); }
    }
};
struct EpiRelu2 {
    static constexpr bool PERM = true, AFTER_DRAIN = false, PREFETCH = false;
    bf16_t* O; int ldc; const float* rs;
    __device__ __forceinline__ void operator()(const f32x4 (&acc)[2][2][4][2], const Unit& u, int wr, int wc, int fr, int fq) const {
        const int row0 = u.pm * BM + wr * 64 + fr; const int col0 = u.pn * BM + wc * 32 + 8 * fq;
        float srv[2][4];
#pragma unroll
        for (int ai = 0; ai < 2; ++ai)
#pragma unroll
            for (int m = 0; m < 4; ++m) srv[ai][m] = rs[row0 + ai * HALF + m * 16];
#pragma unroll
        for (int ai = 0; ai < 2; ++ai)
#pragma unroll
            for (int m = 0; m < 4; ++m) { const int r = row0 + ai * HALF + m * 16; bf16_t* rowp = O + (size_t)r * ldc + col0; const float sr = srv[ai][m];
#pragma unroll
                for (int bj = 0; bj < 2; ++bj) { f32x4 v0 = acc[ai][bj][m][0], v1 = acc[ai][bj][m][1];
#pragma unroll
                    for (int e = 0; e < 4; ++e) { const float a = fmaxf(v0[e], 0.f) * sr, b = fmaxf(v1[e], 0.f) * sr; v0[e] = a * a; v1[e] = b * b; }
                    *(u32x4*)(rowp + bj * HALF) = pack8(v0, v1); } }
    }
};
__device__ __forceinline__ float relu1(float v) { float m; asm("v_max_f32 %0, 0, %1" : "=v"(m) : "v"(v)); return m; }
struct EpiRelu2Raw {
    static constexpr bool PERM = true, AFTER_DRAIN = false, PREFETCH = false;
    bf16_t* O; int ldc;
    __device__ __forceinline__ void operator()(const f32x4 (&acc)[2][2][4][2], const Unit& u, int wr, int wc, int fr, int fq) const {
        const int row0 = u.pm * BM + wr * 64 + fr; const int col0 = u.pn * BM + wc * 32 + 8 * fq;
#pragma unroll
        for (int ai = 0; ai < 2; ++ai)
#pragma unroll
            for (int m = 0; m < 4; ++m) { const int rl = wr * 64 + fr + ai * HALF + m * 16;
                bf16_t* rowp = O + (size_t)u.pm * BM * ldc + (size_t)(col0 >> 6) * (BM * BK) + rl * BK + (col0 & 63);
#pragma unroll
                for (int bj = 0; bj < 2; ++bj) { const f32x4 a0 = acc[ai][bj][m][0], a1 = acc[ai][bj][m][1];
                    const f32x4 m0 = {relu1(a0[0]), relu1(a0[1]), relu1(a0[2]), relu1(a0[3])}, m1 = {relu1(a1[0]), relu1(a1[1]), relu1(a1[2]), relu1(a1[3])};
                    *(u32x4*)(rowp + bj * 2 * (BM * BK)) = pack8(m0 * m0, m1 * m1); }
                __builtin_amdgcn_sched_barrier(0); }
    }
};
struct EpiConvIn {
    static constexpr bool PERM = true, AFTER_DRAIN = false, PREFETCH = false;
    bf16_t* Bo; bf16_t* Uo; const float* rs;
    __device__ __forceinline__ void operator()(const f32x4 (&acc)[2][2][4][2], const Unit& u, int wr, int wc, int fr, int fq) const {
        const int row0 = u.pm * BM + wr * 64 + fr;
        float srv[2][4];
#pragma unroll
        for (int ai = 0; ai < 2; ++ai)
#pragma unroll
            for (int m = 0; m < 4; ++m) srv[ai][m] = rs[row0 + ai * HALF + m * 16];
        if (u.pn < 4) {
            const int col0 = u.pn * BM + wc * 32 + 8 * fq;
#pragma unroll
            for (int ai = 0; ai < 2; ++ai)
#pragma unroll
                for (int m = 0; m < 4; ++m) { const int r = row0 + ai * HALF + m * 16; bf16_t* rowp = Bo + (size_t)r * 1024 + col0; const float sr = srv[ai][m];
#pragma unroll
                    for (int bj = 0; bj < 2; ++bj) *(u32x4*)(rowp + bj * HALF) = pack8(acc[ai][bj][m][0] * sr, acc[ai][bj][m][1] * sr); }
        } else {
            const int col0 = (u.pn - 4) * HALF + wc * 32 + 8 * fq;
#pragma unroll
            for (int ai = 0; ai < 2; ++ai)
#pragma unroll
                for (int m = 0; m < 4; ++m) { const int r = row0 + ai * HALF + m * 16; bf16_t* rowp = Uo + (size_t)r * 1024 + col0; const float sr = srv[ai][m], s2 = sr * sr;
                    *(u32x4*)rowp = pack8(acc[ai][0][m][0] * acc[ai][1][m][0] * s2, acc[ai][0][m][1] * acc[ai][1][m][1] * s2); }
        }
    }
};

constexpr int NR_ROWS = 32768;
#define PG8_GAS __attribute__((address_space(1)))
#define PG8_RLX_AGENT __ATOMIC_RELAXED, __HIP_MEMORY_SCOPE_AGENT
template <bool F32OUT>
struct EpiNormRes {
    static constexpr bool PERM = true, AFTER_DRAIN = false, PREFETCH = false;
    const bf16_t* Hin; bf16_t* Hout; float* Fout;
    const float* gain; float* rs_out;
    float* sq_part; unsigned* cnt;
    unsigned long long* gran; unsigned tag;
    const float* ys;
    PG8_LAS float* xa; PG8_LAS float* xb; PG8_LAS float* sarr;
    const PG8_LAS float* glds;
    __device__ __forceinline__ void operator()(const f32x4 (&acc)[2][2][4][2], const Unit& u, int wr, int wc, int fr_in, int fq_in) const {
        int fr = fr_in, fq = fq_in; asm volatile("" : "+v"(fr), "+v"(fq));
        const int rl0 = wr * 64 + fr, wid = wr * 4 + wc, lane = fr + 16 * fq;
        const size_t row0 = (size_t)u.pm * BM + rl0; const int col0 = u.pn * BM + wc * 32 + 8 * fq;
        u32x4 yb[2][4][2];
#pragma unroll
        for (int ai = 0; ai < 2; ++ai)
#pragma unroll
            for (int m = 0; m < 4; ++m)
#pragma unroll
                for (int bj = 0; bj < 2; ++bj) yb[ai][m][bj] = pack8(acc[ai][bj][m][0], acc[ai][bj][m][1]);
        __builtin_amdgcn_sched_barrier(0);
        u32x4 hv[2][4][2];
#pragma unroll
        for (int ai = 0; ai < 2; ++ai)
#pragma unroll
            for (int m = 0; m < 4; ++m)
#pragma unroll
                for (int bj = 0; bj < 2; ++bj) hv[ai][m][bj] = *(const u32x4*)(Hin + (row0 + ai * HALF + m * 16) * 1024 + col0 + bj * HALF);
        __builtin_amdgcn_sched_barrier(0);
#pragma unroll
        for (int ai = 0; ai < 2; ++ai)
#pragma unroll
            for (int m = 0; m < 4; ++m) { f32x4 q = {0.f, 0.f, 0.f, 0.f};
#pragma unroll
                for (int bj = 0; bj < 2; ++bj) { const u32x4 yw = yb[ai][m][bj];
                    const f32x4 y0 = {__uint_as_float(yw.x << 16), __uint_as_float(yw.x & 0xffff0000u), __uint_as_float(yw.y << 16), __uint_as_float(yw.y & 0xffff0000u)},
                                y1 = {__uint_as_float(yw.z << 16), __uint_as_float(yw.z & 0xffff0000u), __uint_as_float(yw.w << 16), __uint_as_float(yw.w & 0xffff0000u)};
                    q += y0 * y0; q += y1 * y1; }
                float p = (q[0] + q[1]) + (q[2] + q[3]); p += __shfl_xor(p, 16); p += __shfl_xor(p, 32);
                if (fq == 0) xa[(rl0 + ai * HALF + m * 16) * 4 + wc] = p; }
#pragma unroll
        for (int ai = 0; ai < 2; ++ai)
#pragma unroll
            for (int m = 0; m < 4; ++m)
#pragma unroll
                for (int bj = 0; bj < 2; ++bj) asm volatile("" : "+v"(yb[ai][m][bj]));
        asm volatile("s_waitcnt lgkmcnt(0)" ::: "memory");
        __builtin_amdgcn_s_barrier();
        if (wid < 4) {
            const int t = wid * 64 + lane;
            const size_t grow = (size_t)u.pm * BM + t;
            float y2 = ys ? ys[grow] : 1.f; y2 *= y2;
            const f32x4 v = *(const PG8_LAS f32x4*)(xa + t * 4);
            const float own = (((v[0] + v[1]) + v[2]) + v[3]) * (y2 * y2);
            PG8_GAS unsigned long long* gp = (PG8_GAS unsigned long long*)gran + grow;
            __hip_atomic_store(gp + (size_t)u.pn * NR_ROWS, ((unsigned long long)tag << 32) | __float_as_uint(own), PG8_RLX_AGENT);
            unsigned long long g0, g1, g2, g3;
            for (unsigned spins = 0;;) {
                g0 = __hip_atomic_load(gp, PG8_RLX_AGENT); g1 = __hip_atomic_load(gp + NR_ROWS, PG8_RLX_AGENT); g2 = __hip_atomic_load(gp + 2 * NR_ROWS, PG8_RLX_AGENT); g3 = __hip_atomic_load(gp + 3 * NR_ROWS, PG8_RLX_AGENT);
                const bool ok = (unsigned)(g0 >> 32) == tag && (unsigned)(g1 >> 32) == tag && (unsigned)(g2 >> 32) == tag && (unsigned)(g3 >> 32) == tag;
                if (__all(ok)) break;
                __builtin_amdgcn_s_sleep(1);
                if (++spins > (1u << 20)) break;
            }
            const float tot = ((__uint_as_float((unsigned)g0) + __uint_as_float((unsigned)g1)) + __uint_as_float((unsigned)g2)) + __uint_as_float((unsigned)g3);
            sarr[t] = y2 / sqrtf(tot * (1.f / 1024.f) + 1e-6f);
        }
        asm volatile("s_waitcnt lgkmcnt(0)" ::: "memory");
        __builtin_amdgcn_s_barrier();
        f32x4 gv[2][2];
#pragma unroll
        for (int bj = 0; bj < 2; ++bj)
#pragma unroll
            for (int n = 0; n < 2; ++n) gv[bj][n] = *(const PG8_LAS f32x4*)(glds + col0 + bj * HALF + 4 * n);
        float sv[2][4];
#pragma unroll
        for (int ai = 0; ai < 2; ++ai)
#pragma unroll
            for (int m = 0; m < 4; ++m) sv[ai][m] = sarr[rl0 + ai * HALF + m * 16];
#pragma unroll
        for (int ai = 0; ai < 2; ++ai)
#pragma unroll
            for (int m = 0; m < 4; ++m) { const float s = sv[ai][m]; const size_t off = (row0 + ai * HALF + m * 16) * 1024 + col0; f32x4 q = {0.f, 0.f, 0.f, 0.f};
#pragma unroll
                for (int bj = 0; bj < 2; ++bj) { const u32x4 h = hv[ai][m][bj], yw = yb[ai][m][bj];
                    const f32x4 h0 = {__uint_as_float(h.x << 16), __uint_as_float(h.x & 0xffff0000u), __uint_as_float(h.y << 16), __uint_as_float(h.y & 0xffff0000u)},
                                h1 = {__uint_as_float(h.z << 16), __uint_as_float(h.z & 0xffff0000u), __uint_as_float(h.w << 16), __uint_as_float(h.w & 0xffff0000u)},
                                y0 = {__uint_as_float(yw.x << 16), __uint_as_float(yw.x & 0xffff0000u), __uint_as_float(yw.y << 16), __uint_as_float(yw.y & 0xffff0000u)},
                                y1 = {__uint_as_float(yw.z << 16), __uint_as_float(yw.z & 0xffff0000u), __uint_as_float(yw.w << 16), __uint_as_float(yw.w & 0xffff0000u)};
                    const f32x4 v0 = h0 + (y0 * s) * gv[bj][0], v1 = h1 + (y1 * s) * gv[bj][1];
                    if constexpr (F32OUT) { *(f32x4*)(Fout + off + bj * HALF) = v0; *(f32x4*)(Fout + off + bj * HALF + 4) = v1; }
                    else { *(u32x4*)(Hout + off + bj * HALF) = pack8(v0, v1); q += v0 * v0; q += v1 * v1; } }
                if constexpr (!F32OUT) { float p = (q[0] + q[1]) + (q[2] + q[3]); p += __shfl_xor(p, 16); p += __shfl_xor(p, 32); if (fq == 0) xb[(rl0 + ai * HALF + m * 16) * 4 + wc] = p; }
                __builtin_amdgcn_sched_barrier(0); }
        if constexpr (!F32OUT) {
            asm volatile("s_waitcnt lgkmcnt(0)" ::: "memory");
            __builtin_amdgcn_s_barrier();
            if (wid < 4) { const int t = wid * 64 + lane; const f32x4 v = *(const PG8_LAS f32x4*)(xb + t * 4);
                const size_t grow = (size_t)u.pm * BM + t;
                PG8_GAS unsigned* sp = (PG8_GAS unsigned*)sq_part + grow;
                __hip_atomic_store(sp + (size_t)u.pn * NR_ROWS, __float_as_uint(((v[0] + v[1]) + v[2]) + v[3]), PG8_RLX_AGENT);
                asm volatile("s_waitcnt vmcnt(0)" ::: "memory");
                unsigned old = 0u;
                if (lane == 0) old = __hip_atomic_fetch_add((PG8_GAS unsigned*)cnt + ((size_t)u.pm * 4 + wid) * 16, 1u, PG8_RLX_AGENT);
                old = (unsigned)__builtin_amdgcn_readfirstlane((int)old);
                if (old == 3u) {
                    __builtin_amdgcn_fence(__ATOMIC_ACQUIRE, "agent");
                    const float q0 = __uint_as_float(__hip_atomic_load(sp, PG8_RLX_AGENT)), q1 = __uint_as_float(__hip_atomic_load(sp + NR_ROWS, PG8_RLX_AGENT)),
                                q2 = __uint_as_float(__hip_atomic_load(sp + 2 * NR_ROWS, PG8_RLX_AGENT)), q3 = __uint_as_float(__hip_atomic_load(sp + 3 * NR_ROWS, PG8_RLX_AGENT));
                    rs_out[grow] = 1.f / sqrtf((((q0 + q1) + q2) + q3) * (1.f / 1024.f) + 1e-6f);
                } }
        }
    }
};
template <class Epi, class Sched, bool ALIGN_EPI = false, bool SP2 = false>
__device__ __forceinline__ void gemm_phase(PG8_LAS unsigned char* lds, const Gemm g, const Sched& S, const Epi& E) {
    int tid_ = threadIdx.x; asm volatile("" : "+v"(tid_));
    const int tid = tid_, wid = __builtin_amdgcn_readfirstlane(tid >> 6), lane = tid & 63, wr = wid >> 2, wc = wid & 3, fr = lane & 15, fq = lane >> 4;
    const int K = g.K, nt = K / BK;
    unsigned voffA[2], voffB[2];
#pragma unroll
    for (int i = 0; i < 2; ++i) { int R, C; stage_rc(tid * 16 + i * 8192, R, C); const int Rb = Epi::PERM ? ((R & ~31) + perm32(R & 31)) : R;
        voffA[i] = (unsigned)(R * (g.ablk ? BK : K) + C) * 2u; voffB[i] = (unsigned)(Rb * (g.bblk ? BK : K) + C) * 2u; }
    const size_t kstep = (size_t)(BK * 2);
    const size_t hstep = (size_t)HALF * K * 2;
    const size_t tstep = 2 * hstep;
    const size_t kstepA = g.ablk ? (size_t)BM * BK * 2 : kstep, hstepA = g.ablk ? (size_t)HALF * BK * 2 : hstep, kstepB = g.bblk ? (size_t)BM * BK * 2 : kstep, hstepB = g.bblk ? (size_t)HALF * BK * 2 : hstep;
    const unsigned ldsw = (unsigned)wid * 1024u;
    const int aoff = lds_byte(wr * 64 + fr, fq * 8), boff = lds_byte(wc * 32 + fr, fq * 8);
#define PG8_SA(b, h) (((b) * 2 + (h)) * HTB)
#define PG8_SB(b, h) ((4 + (b) * 2 + (h)) * HTB)
#define PG8_STAGE(bufoff, gbase, voff) do { _Pragma("unroll") for (int _i = 0; _i < 2; ++_i) \
        __builtin_amdgcn_global_load_lds((const unsigned*)((const char*)(gbase) + (voff)[_i]), (PG8_LAS unsigned*)(lds + (bufoff) + ldsw + _i * 8192), 16, 0, 0); } while (0)
#define PG8_LDA(dst, b, h) do { _Pragma("unroll") for (int m = 0; m < 4; ++m) _Pragma("unroll") for (int k = 0; k < 2; ++k) dst[m][k] = *(const PG8_LAS bf16x8*)(lds + PG8_SA(b, h) + aoff + m * 2048 + k * 1024); } while (0)
#define PG8_LDB(dst, b, h) do { _Pragma("unroll") for (int n = 0; n < 2; ++n) _Pragma("unroll") for (int k = 0; k < 2; ++k) dst[n][k] = *(const PG8_LAS bf16x8*)(lds + PG8_SB(b, h) + boff + n * 2048 + k * 1024); } while (0)
#define PG8_MMA(ai, bj, At, Bt) do { __builtin_amdgcn_s_setprio(1); _Pragma("unroll") for (int m = 0; m < 4; ++m) _Pragma("unroll") for (int n = 0; n < 2; ++n) _Pragma("unroll") for (int k = 0; k < 2; ++k) \
        acc[ai][bj][m][n] = __builtin_amdgcn_mfma_f32_16x16x32_bf16(Bt[n][k], At[m][k], acc[ai][bj][m][n], 0, 0, 0); __builtin_amdgcn_s_setprio(0); } while (0)
#define PG8_MMA_NP(ai, bj, At, Bt) do { _Pragma("unroll") for (int m = 0; m < 4; ++m) _Pragma("unroll") for (int n = 0; n < 2; ++n) _Pragma("unroll") for (int k = 0; k < 2; ++k) \
        acc[ai][bj][m][n] = __builtin_amdgcn_mfma_f32_16x16x32_bf16(Bt[n][k], At[m][k], acc[ai][bj][m][n], 0, 0, 0); } while (0)
#define PG8_WAIT_V(n) asm volatile("s_waitcnt vmcnt(" #n ")" ::: "memory")
#define PG8_WAIT_L(n) asm volatile("s_waitcnt lgkmcnt(" #n ")" ::: "memory")
#define PG8_BAR __builtin_amdgcn_s_barrier()
#define PG8_SCHED __builtin_amdgcn_sched_barrier(0)
    Unit cur, nxt; int ui = 0;
    if (!S.next(0, cur)) return;
    f32x4 acc[2][2][4][2];
#pragma unroll
    for (int a = 0; a < 2; ++a)
#pragma unroll
        for (int b = 0; b < 2; ++b)
#pragma unroll
            for (int m = 0; m < 4; ++m)
#pragma unroll
                for (int n = 0; n < 2; ++n) acc[a][b][m][n] = (f32x4){0.f, 0.f, 0.f, 0.f};
    bf16x8 At[4][2], B0[2][2], B1[2][2];
    const char* cA = (const char*)g.A + (size_t)cur.pm * tstep; const char* cB = (const char*)g.Bt + (size_t)cur.pn * tstep;
    S.a_ready(cur);
    if constexpr (SP2) {
        PG8_STAGE(PG8_SB(0, 0), cB, voffB); PG8_STAGE(PG8_SB(0, 1), cB + hstepB, voffB); PG8_STAGE(PG8_SA(0, 0), cA, voffA); PG8_STAGE(PG8_SA(0, 1), cA + hstepA, voffA);
        if (wr == 1) PG8_BAR;
        PG8_WAIT_V(2); PG8_BAR;
        PG8_STAGE(PG8_SB(1, 0), cB + kstepB, voffB); PG8_STAGE(PG8_SA(1, 0), cA + kstepA, voffA); PG8_STAGE(PG8_SB(1, 1), cB + hstepB + kstepB, voffB);
        PG8_WAIT_V(6); PG8_BAR;
    } else {
        PG8_STAGE(PG8_SB(0, 0), cB, voffB); PG8_STAGE(PG8_SA(0, 0), cA, voffA); PG8_STAGE(PG8_SB(0, 1), cB + hstepB, voffB); PG8_STAGE(PG8_SA(0, 1), cA + hstepA, voffA);
        if (wr == 1) PG8_BAR;
        PG8_WAIT_V(4); PG8_BAR;
        PG8_STAGE(PG8_SB(1, 0), cB + kstepB, voffB); PG8_STAGE(PG8_SA(1, 0), cA + kstepA, voffA); PG8_STAGE(PG8_SB(1, 1), cB + hstepB + kstepB, voffB);
        PG8_WAIT_V(6); PG8_BAR;
    }
    for (;;) {
        const bool has_next = S.next(ui + 1, nxt);
        const char* nA = has_next ? (const char*)g.A + (size_t)nxt.pm * tstep : cA; const char* nB = has_next ? (const char*)g.Bt + (size_t)nxt.pn * tstep : cB;
        for (int t = 0; t < nt; t += 2) {
            const bool last = (t == nt - 2);
            const char* a1 = cA + (size_t)(t + 1) * kstepA;
            const char* a2 = last ? nA : cA + (size_t)(t + 2) * kstepA; const char* b2 = last ? nB : cB + (size_t)(t + 2) * kstepB;
            const char* a3 = a2 + kstepA; const char* b3 = b2 + kstepB;
            if (last && has_next) S.a_ready(nxt);
            if constexpr (SP2) {
            PG8_LDB(B0, 0, 0); PG8_LDB(B1, 0, 1); PG8_SCHED; PG8_LDA(At, 0, 0); PG8_STAGE(PG8_SA(1, 1), a1 + hstepA, voffA);
            PG8_WAIT_V(8); PG8_WAIT_L(0); __builtin_amdgcn_s_setprio(1); PG8_BAR; PG8_MMA_NP(0, 0, At, B0); PG8_MMA_NP(0, 1, At, B1); __builtin_amdgcn_s_setprio(0); PG8_BAR; PG8_SCHED;
            PG8_LDA(At, 0, 1); PG8_STAGE(PG8_SB(0, 0), b2, voffB); PG8_STAGE(PG8_SB(0, 1), b2 + hstepB, voffB); PG8_STAGE(PG8_SA(0, 0), a2, voffA);
            PG8_WAIT_V(8); PG8_WAIT_L(0); __builtin_amdgcn_s_setprio(1); PG8_BAR; PG8_MMA_NP(1, 0, At, B0); PG8_MMA_NP(1, 1, At, B1); __builtin_amdgcn_s_setprio(0); PG8_BAR; PG8_SCHED;
            PG8_LDB(B0, 1, 0); PG8_LDB(B1, 1, 1); PG8_SCHED; PG8_LDA(At, 1, 0); PG8_STAGE(PG8_SA(0, 1), a2 + hstepA, voffA);
            PG8_WAIT_V(8); PG8_WAIT_L(0); __builtin_amdgcn_s_setprio(1); PG8_BAR; PG8_MMA_NP(0, 0, At, B0); PG8_MMA_NP(0, 1, At, B1); __builtin_amdgcn_s_setprio(0); PG8_BAR; PG8_SCHED;
            PG8_LDA(At, 1, 1); PG8_STAGE(PG8_SB(1, 0), b3, voffB); PG8_STAGE(PG8_SB(1, 1), b3 + hstepB, voffB); PG8_STAGE(PG8_SA(1, 0), a3, voffA);
            PG8_WAIT_V(8); PG8_WAIT_L(0); __builtin_amdgcn_s_setprio(1); PG8_BAR; PG8_MMA_NP(1, 0, At, B0); PG8_MMA_NP(1, 1, At, B1); __builtin_amdgcn_s_setprio(0); PG8_BAR; PG8_SCHED;
            } else {
            PG8_LDB(B0, 0, 0); PG8_SCHED; PG8_LDA(At, 0, 0); PG8_STAGE(PG8_SA(1, 1), a1 + hstepA, voffA);
            PG8_WAIT_L(8); PG8_BAR; PG8_WAIT_L(0); PG8_MMA(0, 0, At, B0); PG8_BAR; PG8_SCHED;
            PG8_LDB(B1, 0, 1); PG8_STAGE(PG8_SB(0, 0), b2, voffB);
            PG8_BAR; PG8_WAIT_L(0); PG8_MMA(0, 1, At, B1); PG8_BAR;
            PG8_LDA(At, 0, 1); PG8_STAGE(PG8_SA(0, 0), a2, voffA);
            PG8_BAR; PG8_WAIT_L(0); PG8_MMA(1, 0, At, B0); PG8_BAR; PG8_SCHED;
            PG8_STAGE(PG8_SB(0, 1), b2 + hstepB, voffB);
            PG8_WAIT_V(6); PG8_BAR; PG8_MMA(1, 1, At, B1); PG8_BAR;
            PG8_LDB(B0, 1, 0); PG8_SCHED; PG8_LDA(At, 1, 0); PG8_STAGE(PG8_SA(0, 1), a2 + hstepA, voffA);
            PG8_WAIT_L(8); PG8_BAR; PG8_WAIT_L(0); PG8_MMA(0, 0, At, B0); PG8_BAR; PG8_SCHED;
            PG8_LDB(B1, 1, 1); PG8_STAGE(PG8_SB(1, 0), b3, voffB);
            PG8_BAR; PG8_WAIT_L(0); PG8_MMA(0, 1, At, B1); PG8_BAR;
            PG8_LDA(At, 1, 1); PG8_STAGE(PG8_SA(1, 0), a3, voffA);
            PG8_BAR; PG8_WAIT_L(0); PG8_MMA(1, 0, At, B0); PG8_BAR; PG8_SCHED;
            PG8_STAGE(PG8_SB(1, 1), b3 + hstepB, voffB);
            PG8_WAIT_V(6); PG8_BAR; PG8_MMA(1, 1, At, B1); PG8_BAR;
            }
        }
        if constexpr (ALIGN_EPI) { if (wr == 0) PG8_BAR; }
        if constexpr (!Epi::AFTER_DRAIN) { E(acc, cur, wr, wc, fr, fq); S.done(cur); }
        if (!has_next) break;
#pragma unroll
        for (int a = 0; a < 2; ++a)
#pragma unroll
            for (int b = 0; b < 2; ++b)
#pragma unroll
                for (int m = 0; m < 4; ++m)
#pragma unroll
                    for (int n = 0; n < 2; ++n) acc[a][b][m][n] = (f32x4){0.f, 0.f, 0.f, 0.f};
        cur = nxt; cA = nA; cB = nB; ++ui;
        if constexpr (ALIGN_EPI) { if (wr == 1) PG8_BAR; }
    }
    PG8_WAIT_V(0);
    if constexpr (!ALIGN_EPI) { if (wr == 0) PG8_BAR; }
    PG8_BAR;
    if constexpr (Epi::AFTER_DRAIN) { E.fused(acc, cur, wr, wc, fr, fq, lds, wid, lane); S.done(cur); }
#undef PG8_SA
#undef PG8_SB
#undef PG8_STAGE
#undef PG8_LDA
#undef PG8_LDB
#undef PG8_MMA
#undef PG8_MMA_NP
#undef PG8_WAIT_V
#undef PG8_WAIT_L
#undef PG8_BAR
#undef PG8_SCHED
}
}
#define GAS __attribute__((address_space(1)))
#define LAS __attribute__((address_space(3)))
typedef unsigned short bf16;
typedef unsigned v4u __attribute__((ext_vector_type(4)));
typedef float f32x4 __attribute__((ext_vector_type(4)));
typedef short bf16x8 __attribute__((ext_vector_type(8)));
typedef GAS unsigned gu32;
typedef GAS unsigned long long gu64;
#define RLX_AGENT __ATOMIC_RELAXED, __HIP_MEMORY_SCOPE_AGENT
#define LDS_WAIT() asm volatile("s_waitcnt lgkmcnt(0)" ::: "memory")
#define VM_WAIT() asm volatile("s_waitcnt vmcnt(0)" ::: "memory")
__device__ __forceinline__ unsigned long long rt() { return __builtin_amdgcn_s_memrealtime(); }
__device__ __forceinline__ unsigned f2bf(float f) { unsigned u = __builtin_bit_cast(unsigned, f); return (u + 0x7fffu + ((u >> 16) & 1u)) >> 16; }
__device__ __forceinline__ unsigned pk2(float lo, float hi) { return f2bf(lo) | (f2bf(hi) << 16); }
#define XB_TMO      128
#define XB_XCNT(j)  (256  + 64 * (j))
#define XB_XSUB(j)  (1280 + 64 * (j))
#define XB_XGEN(j)  (2304 + 64 * (j))
#define XB_TOP      3328
#define XB_TOPGEN   3392
#define XCD_BAR_WORDS 3456
#define XB_SPIN_CAP (1u << 18)

__device__ __forceinline__ unsigned xb_ld(unsigned* p)              { return __hip_atomic_load(p, __ATOMIC_RELAXED, __HIP_MEMORY_SCOPE_AGENT); }
__device__ __forceinline__ unsigned xb_add(unsigned* p, unsigned v) { return __hip_atomic_fetch_add(p, v, __ATOMIC_RELAXED, __HIP_MEMORY_SCOPE_AGENT); }
__device__ __forceinline__ unsigned xb_xcc_id() { return (unsigned)__builtin_amdgcn_s_getreg((3 << 11) | 20) & 0xFu; }
#define XB_SPIN(cond, bar) do { unsigned _sp = 0; while (cond) { __builtin_amdgcn_s_sleep(1); \
    if ((++_sp & 255u) == 0u) { if (xb_ld(&(bar)[XB_TMO])) break; if (_sp > XB_SPIN_CAP) { atomicAdd(&(bar)[XB_TMO], 1u); break; } } } } while (0)

struct XcdBarrier {
    unsigned* bar; unsigned x;
    volatile LAS unsigned* st;
};

__device__ __forceinline__ XcdBarrier xcd_barrier_post(unsigned* bar, volatile LAS unsigned* st) {
    XcdBarrier b; b.bar = bar; b.x = xb_xcc_id(); b.st = st;
    if (threadIdx.x == 0) (void)xb_add(&bar[XB_XCNT(b.x)], 1u);
    return b;
}
__device__ __forceinline__ void xcd_barrier_complete(unsigned* bar, unsigned x, unsigned& nloc, unsigned& nx) {
    const unsigned G = gridDim.x * gridDim.y * gridDim.z;
    unsigned sum, cnt, mine, sp = 0u;
    for (;;) {
        sum = 0u; cnt = 0u; mine = 0u;
#pragma unroll
        for (unsigned j = 0; j < 16; ++j) { const unsigned c = xb_ld(&bar[XB_XCNT(j)]); sum += c; cnt += (c > 0u) ? 1u : 0u; mine = (j == x) ? c : mine; }
        if (sum == G) break;
        __builtin_amdgcn_s_sleep(1);
        if ((++sp & 255u) == 0u) { if (xb_ld(&bar[XB_TMO])) break; if (sp > XB_SPIN_CAP) { atomicAdd(&bar[XB_TMO], 1u); break; } }
    }
    nloc = mine > 0u ? mine : 1u; nx = cnt > 0u ? cnt : 1u;
}

__device__ __forceinline__ void xcd_barrier(const XcdBarrier& b) {
    asm volatile("s_waitcnt vmcnt(0)" ::: "memory");
    __syncthreads();
    if (threadIdx.x == 0) {
        unsigned* bar = b.bar;
        __builtin_amdgcn_s_waitcnt(0);
        unsigned nloc = b.st[0], nx = b.st[1];
        if (nloc == 0u) { xcd_barrier_complete(bar, b.x, nloc, nx); b.st[0] = nloc; b.st[1] = nx; }
        const unsigned old = xb_add(&bar[XB_XSUB(b.x)], 1u);
        const unsigned gen = old / nloc;
        if (nloc >= 4u && old == gen * nloc + nloc / 2u) asm volatile("buffer_wbl2 sc1" ::: "memory");
        if (old + 1u == (gen + 1u) * nloc) {
            __builtin_amdgcn_fence(__ATOMIC_RELEASE, "agent");
            asm volatile("s_waitcnt vmcnt(0)" ::: "memory");
            const unsigned og = xb_add(&bar[XB_TOP], 1u);
            const unsigned tg = og / nx;
            if (og + 1u == (tg + 1u) * nx) {
#pragma unroll
                for (unsigned j_ = 0; j_ < 16u; ++j_) (void)xb_add(&bar[XB_XGEN(j_)], 1u);
            } else XB_SPIN(xb_ld(&bar[XB_XGEN(b.x)]) == gen, bar);
            __builtin_amdgcn_fence(__ATOMIC_ACQUIRE, "agent");
            asm volatile("s_waitcnt vmcnt(0)" ::: "memory");
        } else {
            XB_SPIN(xb_ld(&bar[XB_XGEN(b.x)]) == gen, bar);
            __builtin_amdgcn_fence(__ATOMIC_ACQUIRE, "agent");
            asm volatile("s_waitcnt vmcnt(0)" ::: "memory");
        }
    }
    __syncthreads();
}
constexpr int NB = 4, S = 8192, D = 1024, NH = 16, HD = 64, FF = 4096, NMETA = 16, DEPTH = 4;
constexpr int M = NB * S;
constexpr float EPS = 1e-6f;
constexpr float QSCALE = 0.125f * 1.4426950408889634f;
constexpr float SB_THRESH = 152.f;
constexpr int NWAVES = 8;

constexpr size_t MiB = 1u << 20, KiB = 1u << 10;
constexpr size_t WS_CTL = 480 * MiB, CTL_BAR_BYTES = 256 * KiB, WS_GRAN = WS_CTL + CTL_BAR_BYTES, WS_CNT = WS_GRAN + 1 * MiB, CTL_ZERO_BYTES = CTL_BAR_BYTES + 1 * MiB + 256 * KiB, WS_SQP = WS_CTL + CTL_ZERO_BYTES;
constexpr size_t WS_META = 1 * MiB;
constexpr size_t MO_HM = 0, MO_HMB = 64 * KiB, MO_BM = 96 * KiB, MO_UM = 128 * KiB, MO_VM = 160 * KiB, MO_YM = 192 * KiB, MO_FM = 224 * KiB, MO_KM = 352 * KiB, MO_VTM = 384 * KiB, MO_RS = 512 * KiB;
constexpr size_t WS_WIN = 2 * MiB, WS_WOUT = 14 * MiB, WS_WQK = 18 * MiB, WS_WV = 22 * MiB, WS_WQ3 = 24 * MiB, WS_WO = 26 * MiB, WS_W1 = 30 * MiB, WS_W2 = 62 * MiB;
constexpr size_t WS_HB = 96 * MiB, WS_R0 = 160 * MiB, WS_K = 224 * MiB, WS_VT = 288 * MiB, WS_R1 = 352 * MiB, WS_R2 = 416 * MiB, WS_MH = 482 * MiB, WS_END = 483 * MiB;
constexpr int CW_BAR = 4096;
static_assert((CW_BAR + 3456) * 4 <= (int)CTL_BAR_BYTES, "barrier words inside the memset region");

constexpr int RING_BYTES = 131072, MISC_OFF = RING_BYTES + 320, LDS_BYTES = 147456;

typedef float f32x16 __attribute__((ext_vector_type(16)));
typedef unsigned u32x2 __attribute__((ext_vector_type(2)));

__device__ __forceinline__ float wave_sum(float v) {
#pragma unroll
    for (int o = 1; o < 64; o <<= 1) v += __shfl_xor(v, o);
    return v;
}
__device__ __forceinline__ float bflo(unsigned w) { return __uint_as_float(w << 16); }
__device__ __forceinline__ float bfhi(unsigned w) { return __uint_as_float(w & 0xffff0000u); }
__device__ __forceinline__ unsigned cvtpk(float lo, float hi) { return pg8::cvt_pk_bf16(lo, hi); }
__device__ __forceinline__ void unpack8(const v4u w, float (&f)[8]) { f[0] = bflo(w.x); f[1] = bfhi(w.x); f[2] = bflo(w.y); f[3] = bfhi(w.y); f[4] = bflo(w.z); f[5] = bfhi(w.z); f[6] = bflo(w.w); f[7] = bfhi(w.w); }

__device__ __forceinline__ void cvt_item(const float* W, int K, int N, bf16* WT, const float* gain, float scale, int mode, LAS float* scr, int item, int lane) {
    const int nblk = N / 32, kb = item / nblk, nb = item % nblk, k0 = 64 * kb, n0 = 32 * nb;
    f32x4 wv[8];
#pragma unroll
    for (int i = 0; i < 8; ++i) wv[i] = *(const f32x4*)(W + (size_t)(k0 + 8 * i + (lane >> 3)) * N + n0 + 4 * (lane & 7));
    const float* gp = gain ? gain + k0 : W;
    float gq[8];
#pragma unroll
    for (int i = 0; i < 8; ++i) gq[i] = gp[8 * i + (lane >> 3)];
#pragma unroll
    for (int i = 0; i < 8; ++i) { const int kk = 8 * i + (lane >> 3); const float gs = gain ? gq[i] * scale : scale; LAS float* d = scr + kk * 33 + 4 * (lane & 7);
        d[0] = wv[i].x * gs; d[1] = wv[i].y * gs; d[2] = wv[i].z * gs; d[3] = wv[i].w * gs; }
    LDS_WAIT(); asm volatile("" ::: "memory");
    int nd0 = n0;
    if (mode == 1 && n0 >= 1024) { const int o = (n0 - 1024) & 1023; nd0 = 1024 + 256 * (o >> 7) + (n0 >= 2048 ? 128 : 0) + (o & 127); }
    const int c = lane & 7;
#pragma unroll
    for (int j = 0; j < 4; ++j) { const int n = (lane >> 3) + 8 * j; const LAS float* s = scr + (8 * c) * 33 + n;
        v4u o; o.x = pk2(s[0 * 33], s[1 * 33]); o.y = pk2(s[2 * 33], s[3 * 33]); o.z = pk2(s[4 * 33], s[5 * 33]); o.w = pk2(s[6 * 33], s[7 * 33]);
        const int nr = nd0 + n;
        *(GAS v4u*)(WT + (size_t)(nr >> 8) * 256 * K + (size_t)(k0 >> 6) * (256 * 64) + (nr & 255) * 64 + 8 * c) = o; }
    LDS_WAIT(); asm volatile("" ::: "memory");
}
__device__ __forceinline__ void norm_row_to_bf16(const float* xrow, bf16* orow, int lane) {
    const f32x4* xr = (const f32x4*)xrow + lane;
    f32x4 v[4]; float s = 0.f;
#pragma unroll
    for (int j = 0; j < 4; ++j) { v[j] = xr[64 * j]; s += (v[j].x * v[j].x + v[j].y * v[j].y) + (v[j].z * v[j].z + v[j].w * v[j].w); }
    const float r = 1.f / sqrtf(wave_sum(s) * (1.f / D) + EPS);
    u32x2* o8 = (u32x2*)orow + lane;
#pragma unroll
    for (int j = 0; j < 4; ++j) { u32x2 w; w.x = cvtpk(v[j].x * r, v[j].y * r); w.y = cvtpk(v[j].z * r, v[j].w * r); o8[64 * j] = w; }
}
template <int NRW>
__device__ __forceinline__ void raw_rows_to_bf16(const float* x0, bf16* o0, float* rs0, int lane) {
    f32x4 v[NRW][4]; float s[NRW];
#pragma unroll
    for (int r = 0; r < NRW; ++r) { const f32x4* xr = (const f32x4*)(x0 + (size_t)r * D) + 2 * lane;
#pragma unroll
        for (int j = 0; j < 2; ++j) { v[r][2 * j] = xr[128 * j]; v[r][2 * j + 1] = xr[128 * j + 1]; } }
#pragma unroll
    for (int r = 0; r < NRW; ++r) { float a = 0.f;
#pragma unroll
        for (int j = 0; j < 4; ++j) a += (v[r][j].x * v[r][j].x + v[r][j].y * v[r][j].y) + (v[r][j].z * v[r][j].z + v[r][j].w * v[r][j].w);
        s[r] = a; }
#pragma unroll
    for (int o = 1; o < 64; o <<= 1) {
#pragma unroll
        for (int r = 0; r < NRW; ++r) s[r] += __shfl_xor(s[r], o); }
#pragma unroll
    for (int r = 0; r < NRW; ++r) {
        if (lane == 0) rs0[r] = 1.f / sqrtf(s[r] * (1.f / D) + EPS);
#pragma unroll
        for (int j = 0; j < 2; ++j) { v4u w; w.x = cvtpk(v[r][2 * j].x, v[r][2 * j].y); w.y = cvtpk(v[r][2 * j].z, v[r][2 * j].w); w.z = cvtpk(v[r][2 * j + 1].x, v[r][2 * j + 1].y); w.w = cvtpk(v[r][2 * j + 1].z, v[r][2 * j + 1].w);
            *((v4u*)(o0 + (size_t)r * D) + lane + 64 * j) = w; } }
}
template <bool HIN32, bool OUT32>
__device__ __forceinline__ void nr_rows16(const bf16* y0, const void* hin0, void* hout0, float* rs0, const float* gain, int lane) {
    float g[16];
#pragma unroll
    for (int j = 0; j < 2; ++j) { const f32x4 g0 = *((const f32x4*)gain + 2 * lane + 128 * j), g1 = *((const f32x4*)gain + 2 * lane + 128 * j + 1);
        g[8 * j] = g0.x; g[8 * j + 1] = g0.y; g[8 * j + 2] = g0.z; g[8 * j + 3] = g0.w; g[8 * j + 4] = g1.x; g[8 * j + 5] = g1.y; g[8 * j + 6] = g1.z; g[8 * j + 7] = g1.w; }
    struct Raw { v4u y[2][2]; v4u hb[2][2]; f32x4 hf[2][4]; };
    auto load = [&](Raw& R, int r0) {
#pragma unroll
        for (int r = 0; r < 2; ++r)
#pragma unroll
            for (int j = 0; j < 2; ++j) { R.y[r][j] = *((const v4u*)(y0 + (size_t)(r0 + r) * D) + lane + 64 * j);
                if constexpr (HIN32) { const f32x4* hp = (const f32x4*)((const float*)hin0 + (size_t)(r0 + r) * D) + 2 * lane + 128 * j; R.hf[r][2 * j] = hp[0]; R.hf[r][2 * j + 1] = hp[1]; }
                else R.hb[r][j] = *((const v4u*)((const bf16*)hin0 + (size_t)(r0 + r) * D) + lane + 64 * j); }
    };
    auto proc = [&](const Raw& R, int r0) {
        float y[2][16], hv[2][16], ss[2], s2[2];
#pragma unroll
        for (int r = 0; r < 2; ++r) { float a = 0.f;
#pragma unroll
            for (int j = 0; j < 2; ++j) { float t[8]; unpack8(R.y[r][j], t);
#pragma unroll
                for (int e = 0; e < 8; ++e) { y[r][8 * j + e] = t[e]; a += t[e] * t[e]; }
                if constexpr (HIN32) { const f32x4 p = R.hf[r][2 * j], q = R.hf[r][2 * j + 1];
                    hv[r][8 * j] = p.x; hv[r][8 * j + 1] = p.y; hv[r][8 * j + 2] = p.z; hv[r][8 * j + 3] = p.w; hv[r][8 * j + 4] = q.x; hv[r][8 * j + 5] = q.y; hv[r][8 * j + 6] = q.z; hv[r][8 * j + 7] = q.w; }
                else { float u[8]; unpack8(R.hb[r][j], u);
#pragma unroll
                    for (int e = 0; e < 8; ++e) hv[r][8 * j + e] = u[e]; } }
            ss[r] = a; }
#pragma unroll
        for (int o = 1; o < 64; o <<= 1) { ss[0] += __shfl_xor(ss[0], o); ss[1] += __shfl_xor(ss[1], o); }
#pragma unroll
        for (int r = 0; r < 2; ++r) { const float ry = 1.f / sqrtf(ss[r] * (1.f / D) + EPS);
#pragma unroll
            for (int e = 0; e < 16; ++e) hv[r][e] += (y[r][e] * ry) * g[e];
            if constexpr (OUT32) {
#pragma unroll
                for (int j = 0; j < 2; ++j) { f32x4* op = (f32x4*)((float*)hout0 + (size_t)(r0 + r) * D) + 2 * lane + 128 * j;
                    op[0] = (f32x4){hv[r][8 * j], hv[r][8 * j + 1], hv[r][8 * j + 2], hv[r][8 * j + 3]}; op[1] = (f32x4){hv[r][8 * j + 4], hv[r][8 * j + 5], hv[r][8 * j + 6], hv[r][8 * j + 7]}; }
            } else { float a = 0.f;
#pragma unroll
                for (int j = 0; j < 2; ++j) { v4u w; w.x = cvtpk(hv[r][8 * j], hv[r][8 * j + 1]); w.y = cvtpk(hv[r][8 * j + 2], hv[r][8 * j + 3]); w.z = cvtpk(hv[r][8 * j + 4], hv[r][8 * j + 5]); w.w = cvtpk(hv[r][8 * j + 6], hv[r][8 * j + 7]);
                    *((v4u*)((bf16*)hout0 + (size_t)(r0 + r) * D) + lane + 64 * j) = w;
                    float t[8]; unpack8(w, t);
#pragma unroll
                    for (int e = 0; e < 8; ++e) a += t[e] * t[e]; }
                s2[r] = a; } }
        if constexpr (!OUT32) {
#pragma unroll
            for (int o = 1; o < 64; o <<= 1) { s2[0] += __shfl_xor(s2[0], o); s2[1] += __shfl_xor(s2[1], o); }
            if (lane == 0) { rs0[r0] = 1.f / sqrtf(s2[0] * (1.f / D) + EPS); rs0[r0 + 1] = 1.f / sqrtf(s2[1] * (1.f / D) + EPS); }
        }
    };
    Raw A, B;
    load(A, 0);
#pragma unroll
    for (int gq = 0; gq < 8; gq += 2) {
        load(B, 2 * (gq + 1));
        proc(A, 2 * gq);
        if (gq + 2 < 8) load(A, 2 * (gq + 2));
        proc(B, 2 * (gq + 1));
    }
}
__device__ __forceinline__ void nr_row(const bf16* yrow, const float* hin, float* hout, bf16* hbrow, const float* gain, int lane) {
    f32x4 hv[4], yv[4]; float ss = 0.f;
#pragma unroll
    for (int j = 0; j < 4; ++j) { const u32x2 w = *((const u32x2*)yrow + lane + 64 * j); yv[j] = (f32x4){bflo(w.x), bfhi(w.x), bflo(w.y), bfhi(w.y)};
        hv[j] = *((const f32x4*)hin + lane + 64 * j); ss += (yv[j].x * yv[j].x + yv[j].y * yv[j].y) + (yv[j].z * yv[j].z + yv[j].w * yv[j].w); }
    const float ry = 1.f / sqrtf(wave_sum(ss) * (1.f / D) + EPS);
    float s2 = 0.f;
#pragma unroll
    for (int j = 0; j < 4; ++j) { const f32x4 g4 = *((const f32x4*)gain + lane + 64 * j); hv[j] = hv[j] + (yv[j] * ry) * g4; *((f32x4*)hout + lane + 64 * j) = hv[j];
        s2 += (hv[j].x * hv[j].x + hv[j].y * hv[j].y) + (hv[j].z * hv[j].z + hv[j].w * hv[j].w); }
    const float rh = 1.f / sqrtf(wave_sum(s2) * (1.f / D) + EPS);
#pragma unroll
    for (int j = 0; j < 4; ++j) { u32x2 w; w.x = cvtpk(hv[j].x * rh, hv[j].y * rh); w.y = cvtpk(hv[j].z * rh, hv[j].w * rh); *((u32x2*)hbrow + lane + 64 * j) = w; }
}
__device__ __forceinline__ f32x4 meta_tile(const bf16* A, const bf16* Wt, int K, int n0, LAS float* red, int wave, int lane) {
    const int kw = K >> 3, kbeg = wave * kw;
    const bf16* ap = A + (size_t)(lane & 15) * K + kbeg + 8 * (lane >> 4);
    const int nn = n0 + (lane & 15); const bf16* bp = Wt + (size_t)(nn >> 8) * 256 * K + (nn & 255) * 64;
    const int kb0 = kbeg + 8 * (lane >> 4);
    f32x4 acc = (f32x4){0.f, 0.f, 0.f, 0.f};
#pragma unroll 8
    for (int k = 0; k < kw; k += 32) { const bf16x8 a = *(const bf16x8*)(ap + k); const int kk = kb0 + k; const bf16x8 b = *(const bf16x8*)(bp + (size_t)(kk >> 6) * (256 * 64) + (kk & 63)); acc = __builtin_amdgcn_mfma_f32_16x16x32_bf16(a, b, acc, 0, 0, 0); }
    *((LAS f32x4*)red + wave * 64 + lane) = acc;
    __syncthreads();
    if (wave == 0) {
#pragma unroll
        for (int w = 1; w < 8; ++w) acc = acc + *((LAS f32x4*)red + w * 64 + lane);
    }
    __syncthreads();
    return acc;
}

template <bool MASKED>
__device__ __forceinline__ void attn_step(const bf16x8 (&ck)[4], const bf16x8 (&cv)[4], const bf16x8 (&qf)[4], f32x16& o0, f32x16& o1, float& Rp, float& Rl, int q, int h, bool metab) {
    f32x16 st;
#pragma unroll
    for (int r = 0; r < 16; ++r) st[r] = 0.f;
    __builtin_amdgcn_s_setprio(1);
#pragma unroll
    for (int s = 0; s < 4; ++s) st = __builtin_amdgcn_mfma_f32_32x32x16_bf16(ck[s], qf[s], st, 0, 0, 0);
    __builtin_amdgcn_s_setprio(0);
    typedef float f32x2 __attribute__((ext_vector_type(2)));
    f32x2 BE[8], OM[8];
#pragma unroll
    for (int j = 0; j < 8; ++j) {
        const f32x2 t = {__builtin_amdgcn_exp2f(-st[j]), __builtin_amdgcn_exp2f(-st[8 + j])};
        const f32x2 d = t + 1.f;
        f32x2 b = {__builtin_amdgcn_rcpf(d.x), __builtin_amdgcn_rcpf(d.y)};
        f32x2 w = 1.f - b;
        if (MASKED) { const int kA = j + 8 * h, kB = j + 8 * h + 16; const bool vA = metab ? (kA < NMETA) : (kA < q), vB = metab ? (kB < NMETA) : (kB < q);
            b.x = vA ? b.x : 0.f; w.x = vA ? w.x : 1.f; b.y = vB ? b.y : 0.f; w.y = vB ? w.y : 1.f; }
        BE[j] = b; OM[j] = w;
    }
    f32x2 pAB[8];
    pAB[7] = (f32x2){1.f, 1.f};
#pragma unroll
    for (int j = 6; j >= 0; --j) pAB[j] = OM[j + 1] * pAB[j + 1];
    const f32x2 TAB = OM[0] * pAB[0];
    const float TA = TAB.x, TB = TAB.y;
    float TAp, TBp;
    { auto ra = __builtin_amdgcn_permlane32_swap(__float_as_uint(TA), __float_as_uint(TA), false, false); TAp = __uint_as_float(h == 0 ? ra[1] : ra[0]);
      auto rb = __builtin_amdgcn_permlane32_swap(__float_as_uint(TB), __float_as_uint(TB), false, false); TBp = __uint_as_float(h == 0 ? rb[1] : rb[0]); }
    const float baseA = ((h == 0) ? (TAp * TB) * TBp : TBp * TB) * Rp;
    const float baseB = ((h == 0) ? TBp : 1.f) * Rp;
    const f32x2 base2 = {baseA, baseB};
    float a[16];
#pragma unroll
    for (int j = 0; j < 8; ++j) { const f32x2 aj = (BE[j] * base2) * pAB[j]; a[j] = aj.x; a[8 + j] = aj.y; }
    const float Tblk = (TA * TAp) * (TB * TBp);
    Rp *= Tblk; Rl -= __builtin_amdgcn_logf(Tblk);
    v4u p0w, p1w;
    p0w.x = cvtpk(a[0], a[1]); p0w.y = cvtpk(a[2], a[3]); p0w.z = cvtpk(a[4], a[5]); p0w.w = cvtpk(a[6], a[7]);
    p1w.x = cvtpk(a[8], a[9]); p1w.y = cvtpk(a[10], a[11]); p1w.z = cvtpk(a[12], a[13]); p1w.w = cvtpk(a[14], a[15]);
    const bf16x8 p0 = __builtin_bit_cast(bf16x8, p0w), p1 = __builtin_bit_cast(bf16x8, p1w);
    __builtin_amdgcn_s_setprio(1);
    o0 = __builtin_amdgcn_mfma_f32_32x32x16_bf16(cv[0], p0, o0, 0, 0, 0); o1 = __builtin_amdgcn_mfma_f32_32x32x16_bf16(cv[2], p0, o1, 0, 0, 0);
    o0 = __builtin_amdgcn_mfma_f32_32x32x16_bf16(cv[1], p1, o0, 0, 0, 0); o1 = __builtin_amdgcn_mfma_f32_32x32x16_bf16(cv[3], p1, o1, 0, 0, 0);
    __builtin_amdgcn_s_setprio(0);
}
constexpr int ATT_PF = 6;
__device__ __forceinline__ void glds16(const void* gsrc, unsigned lds_dst) { unsigned keep;
    asm volatile("s_mov_b32 %0, m0\n\ts_mov_b32 m0, %2\n\ts_nop 0\n\tglobal_load_lds_dwordx4 %1, off\n\ts_mov_b32 m0, %0" : "=&s"(keep) : "v"(gsrc), "s"(lds_dst) : "memory"); }
__device__ __forceinline__ void attn_phase(LAS unsigned char* lds, const bf16* Q, const bf16* Kb, const bf16* Vt, const bf16* Km, const bf16* Vtm, bf16* O, int vcu, int G, int wave, int lane) {
    constexpr int NU = NB * NH * (S / 256);
    int id = vcu;
    if (id >= NU) return;
    const int q = lane & 31, h = lane >> 5;
    const int pi = (q & 0x13) | (((q >> 2) & 1) << 3) | (((q >> 3) & 1) << 2);
    const unsigned lds0 = (unsigned)(size_t)lds;
    const int ddst = (wave < 4) ? wave * 1024 : 4096 + (wave - 4) * 1024;
    const int kx = (pi >> 1) & 7, vx = (q >> 2) & 3;
    int kro[4], vro[4];
#pragma unroll
    for (int s = 0; s < 4; ++s) kro[s] = pi * 128 + (((2 * s + h) ^ kx) << 4);
#pragma unroll
    for (int s = 0; s < 2; ++s) { vro[s] = 4096 + q * 64 + (((2 * s + h) ^ vx) << 4); vro[2 + s] = vro[s] + 32 * 64; }
    volatile LAS unsigned* flags = (volatile LAS unsigned*)(lds + RING_BYTES);
    const bf16* dsrc; size_t dstep; int B0, qblk, hh; size_t rowbase;
    bf16x8 qn[4];
#define DMA_BLOCK(X) do { const int X_ = (X); const int Xc_ = X_ < 0 ? 0 : X_; \
        glds16(dsrc + (size_t)Xc_ * dstep, (unsigned)__builtin_amdgcn_readfirstlane((int)(lds0 + (((X_ & 15) << 13) + ddst)))); } while (0)
#define UNIT_SETUP(ID) do { const int bh_ = (ID) >> 5, ub_ = (ID) & 31; hh = bh_ & 15; rowbase = (size_t)(bh_ >> 4) * S; B0 = ub_ * 8; qblk = B0 + wave; \
        { const bf16* qp_ = Q + (rowbase + (size_t)qblk * 32 + q) * D + hh * HD + 8 * h; _Pragma("unroll") for (int s = 0; s < 4; ++s) qn[s] = *(const bf16x8*)(qp_ + 16 * s); } \
        if (wave < 4) { const int r_ = 8 * wave + (lane >> 3), c_ = (lane & 7) ^ ((r_ >> 1) & 7); dsrc = Kb + (rowbase + r_) * D + hh * HD + c_ * 8; dstep = (size_t)32 * D; } \
        else { const int d_ = 16 * (wave - 4) + (lane >> 2), c_ = (lane & 3) ^ ((d_ >> 2) & 3); dsrc = Vt + (size_t)(hh * HD + d_) * M + rowbase + c_ * 8; dstep = 32; } \
        _Pragma("unroll") for (int X = 7; X >= 1 - ATT_PF; --X) DMA_BLOCK(B0 + X); } while (0)
    UNIT_SETUP(id);
    for (;;) {
        bf16x8 qf[4];
#pragma unroll
        for (int s = 0; s < 4; ++s) qf[s] = qn[s];
        asm volatile("" : "+v"(qf[0]), "+v"(qf[1]), "+v"(qf[2]), "+v"(qf[3]));
        f32x16 o0, o1;
#pragma unroll
        for (int r = 0; r < 16; ++r) { o0[r] = 0.f; o1[r] = 0.f; }
        float Rp = 1.f, Rl = 0.f; bool done = false;
        for (int i = 0;; ++i) {
            asm volatile("s_waitcnt vmcnt(5) lgkmcnt(0)" ::: "memory");
            __builtin_amdgcn_s_barrier();
            asm volatile("" ::: "memory");
            if (i > 0) { const LAS unsigned* fp = (const LAS unsigned*)(lds + RING_BYTES) + ((i - 1) & 1) * 8;
                const v4u fa = *(const LAS v4u*)fp, fb = *(const LAS v4u*)(fp + 4);
                const unsigned all_done = (fa.x & fa.y & fa.z & fa.w) & (fb.x & fb.y & fb.z & fb.w);
                if (__builtin_amdgcn_readfirstlane(all_done)) break; }
            DMA_BLOCK(B0 - i - ATT_PF);
            if (!done) {
                const int jb = qblk - i;
                bf16x8 ck[4], cv[4];
                if (jb >= 0) {
                    const LAS unsigned char* sb = lds + ((jb & 15) << 13);
#pragma unroll
                    for (int s = 0; s < 4; ++s) { ck[s] = *(const LAS bf16x8*)(sb + kro[s]); cv[s] = *(const LAS bf16x8*)(sb + vro[s]); }
                    if (i == 0) attn_step<true>(ck, cv, qf, o0, o1, Rp, Rl, q, h, false); else attn_step<false>(ck, cv, qf, o0, o1, Rp, Rl, q, h, false);
                } else {
                    const bf16* kmp = Km + (size_t)(pi & 15) * D + hh * HD + 8 * h; const bf16* vmp = Vtm + (size_t)(hh * HD + q) * NMETA + 8 * h;
#pragma unroll
                    for (int s = 0; s < 4; ++s) ck[s] = *(const bf16x8*)(kmp + 16 * s);
                    cv[0] = *(const bf16x8*)(vmp); cv[1] = cv[0]; cv[2] = *(const bf16x8*)(vmp + 32 * NMETA); cv[3] = cv[2];
                    attn_step<true>(ck, cv, qf, o0, o1, Rp, Rl, q, h, true);
                    done = true;
                }
                if (__all(Rl > SB_THRESH)) done = true;
            }
            if (lane == 0) flags[(i & 1) * 8 + wave] = done ? 0xffffffffu : 0u;
        }
        bf16* op = O + (rowbase + (size_t)qblk * 32 + q) * D + hh * HD + 4 * h;
        const int nid = id + G; const bool more = nid < NU;
        if (more) UNIT_SETUP(nid);
#pragma unroll
        for (int g = 0; g < 4; ++g) { u32x2 w0, w1; w0.x = cvtpk(o0[4 * g], o0[4 * g + 1]); w0.y = cvtpk(o0[4 * g + 2], o0[4 * g + 3]); w1.x = cvtpk(o1[4 * g], o1[4 * g + 1]); w1.y = cvtpk(o1[4 * g + 2], o1[4 * g + 3]);
            *(u32x2*)(op + 8 * g) = w0; *(u32x2*)(op + 32 + 8 * g) = w1; }
        if (!more) break;
        id = nid;
    }
#undef UNIT_SETUP
#undef DMA_BLOCK
    asm volatile("s_waitcnt vmcnt(0) lgkmcnt(0)" ::: "memory");
    __builtin_amdgcn_s_barrier();
    asm volatile("" ::: "memory");
}

struct Args { const float* in[13]; float* out; unsigned char* ws; };
__global__ void __launch_bounds__(NWAVES * 64, 2) yoco_fwd(Args args) {
    extern __shared__ __attribute__((aligned(16))) unsigned char lds_raw[];
    LAS unsigned char* lds = (LAS unsigned char*)lds_raw;
    volatile LAS unsigned* MISC = (volatile LAS unsigned*)(lds + MISC_OFF);
    const int G = gridDim.x, bx = blockIdx.x;
    const int vcu = (G % 8 == 0) ? (bx % 8) * (G / 8) + bx / 8 : bx;
    const int NGW = G * NWAVES;
    const float* x = args.in[0]; const float* meta_tokens = args.in[1]; const float* ng = args.in[2]; const float* conv_in = args.in[3]; const float* conv_w = args.in[4];
    const float* conv_out = args.in[5]; const float* kv_norm = args.in[6]; const float* w_k = args.in[7]; const float* w_v = args.in[8]; const float* w_q = args.in[9];
    const float* w_o = args.in[10]; const float* mlp_w1 = args.in[11]; const float* mlp_w2 = args.in[12];
    float* out = args.out;
    LAS float* red = (LAS float*)lds;
#define PHASE_BEGIN \
    int tid = threadIdx.x; asm volatile("" : "+v"(tid)); \
    const int lane = tid & 63, wave = __builtin_amdgcn_readfirstlane(tid >> 6); \
    GAS unsigned char* wsg_ = (GAS unsigned char*)args.ws; asm volatile("" : "+s"(wsg_)); unsigned char* ws = (unsigned char*)wsg_; \
    const int gw = vcu * NWAVES + wave; (void)gw; (void)lane;
#define Win_t ((bf16*)(ws + WS_WIN))
#define Wout_t ((bf16*)(ws + WS_WOUT))
#define Wqk_t ((bf16*)(ws + WS_WQK))
#define Wv_t ((bf16*)(ws + WS_WV))
#define Wq3_t ((bf16*)(ws + WS_WQ3))
#define Wo_t ((bf16*)(ws + WS_WO))
#define W1_t ((bf16*)(ws + WS_W1))
#define W2_t ((bf16*)(ws + WS_W2))
#define HB ((bf16*)(ws + WS_HB))
#define KB ((bf16*)(ws + WS_K))
#define VT ((bf16*)(ws + WS_VT))
#define R0 ((bf16*)(ws + WS_R0))
#define R1 ((bf16*)(ws + WS_R1))
#define R2 ((bf16*)(ws + WS_R2))
#define hmS(k_) ((float*)(ws + WS_MH) + (size_t)(k_) * NMETA * D)
#define hmbS(k_) ((bf16*)(ws + WS_MH + 256 * KiB) + (size_t)(k_) * NMETA * D)
#define META_NR(k_, gain_) do { const int k__ = (k_); const float* hin_ = (k__ == 0) ? meta_tokens : hmS(k__ - 1); \
        for (int r_ = wave; r_ < NMETA; r_ += NWAVES) nr_row(ym + (size_t)r_ * D, hin_ + (size_t)r_ * D, hmS(k__) + (size_t)r_ * D, hmbS(k__) + (size_t)r_ * D, (gain_), lane); \
        asm volatile("s_waitcnt vmcnt(0)" ::: "memory"); __syncthreads(); } while (0)
#define hmb ((bf16*)(ws + WS_META + MO_HMB))
#define bm ((bf16*)(ws + WS_META + MO_BM))
#define um ((bf16*)(ws + WS_META + MO_UM))
#define vm ((bf16*)(ws + WS_META + MO_VM))
#define ym ((bf16*)(ws + WS_META + MO_YM))
#define fm ((bf16*)(ws + WS_META + MO_FM))
#define km ((bf16*)(ws + WS_META + MO_KM))
#define vtm ((bf16*)(ws + WS_META + MO_VTM))
#define RS ((float*)(ws + WS_META + MO_RS))

    if (threadIdx.x < 32) MISC[threadIdx.x] = 0u;
    __syncthreads();
    XcdBarrier bar = xcd_barrier_post((unsigned*)(args.ws + WS_CTL) + CW_BAR, MISC + 8);
#define GRID_BAR() do { XcdBarrier b_ = bar; b_.x = xb_xcc_id(); GAS unsigned* bg_ = (GAS unsigned*)b_.bar; asm volatile("" : "+s"(bg_)); b_.bar = (unsigned*)bg_; xcd_barrier(b_); } while (0)

    {
        PHASE_BEGIN
        LAS float* scr = (LAS float*)(lds + wave * 16384);
        constexpr int NITEMS = 23552;
        for (int it = gw; it < NITEMS; it += NGW) {
            int r = it;
            if (r < 3072) { const int l = r / 1536; cvt_item(conv_in + (size_t)l * D * 3 * D, D, 3 * D, Win_t + (size_t)l * 3 * D * D, ng + (size_t)(l * 4 + 0) * D, 1.f, 1, scr, r % 1536, lane); continue; } r -= 3072;
            if (r < 1024) { const int l = r / 512; cvt_item(conv_out + (size_t)l * D * D, D, D, Wout_t + (size_t)l * D * D, nullptr, 1.f, 0, scr, r % 512, lane); continue; } r -= 1024;
            if (r < 512) { cvt_item(w_q, D, D, Wqk_t, ng + (size_t)(2 * 4 + 0) * D, QSCALE, 0, scr, r, lane); continue; } r -= 512;
            if (r < 512) { cvt_item(w_k, D, D, Wqk_t + (size_t)D * D, kv_norm, 1.f, 0, scr, r, lane); continue; } r -= 512;
            if (r < 512) { cvt_item(w_v, D, D, Wv_t, kv_norm, 1.f, 0, scr, r, lane); continue; } r -= 512;
            if (r < 512) { cvt_item(w_q + (size_t)D * D, D, D, Wq3_t, ng + (size_t)(3 * 4 + 0) * D, QSCALE, 0, scr, r, lane); continue; } r -= 512;
            if (r < 1024) { const int l = r / 512; cvt_item(w_o + (size_t)l * D * D, D, D, Wo_t + (size_t)l * D * D, nullptr, 1.f, 0, scr, r % 512, lane); continue; } r -= 1024;
            if (r < 8192) { const int l = r / 2048; cvt_item(mlp_w1 + (size_t)l * D * FF, D, FF, W1_t + (size_t)l * FF * D, ng + (size_t)(l * 4 + 2) * D, 1.f, 0, scr, r % 2048, lane); continue; } r -= 8192;
            { const int l = r / 2048; cvt_item(mlp_w2 + (size_t)l * FF * D, FF, D, W2_t + (size_t)l * D * FF, nullptr, 1.f, 0, scr, r % 2048, lane); }
        }
        {
            const int rows_it = NGW * 4; const int nit = (gw * 4 < M) ? (M - gw * 4 + rows_it - 1) / rows_it : 0; const int nr = 4 * nit;
            const unsigned ringw = (unsigned)(size_t)lds + (unsigned)wave * 16384u;
            LAS unsigned char* ringp = lds + wave * 16384;
#define XROW(r_) ((size_t)(gw * 4) + (size_t)((r_) >> 2) * rows_it + ((r_) & 3))
#define XISSUE(r_) do { const float* src_ = x + XROW(r_) * D + 4 * lane; const unsigned dst_ = ringw + (unsigned)((r_) & 3) * 4096u; \
                _Pragma("unroll") for (int j_ = 0; j_ < 4; ++j_) glds16(src_ + 256 * j_, dst_ + j_ * 1024); } while (0)
            for (int r = 0; r < 4 && r < nr; ++r) XISSUE(r);
#pragma clang loop unroll(disable)
            for (int r = 0; r < nr; ++r) {
                if (r + 3 < nr) asm volatile("s_waitcnt vmcnt(12)" ::: "memory"); else asm volatile("s_waitcnt vmcnt(0)" ::: "memory");
                f32x4 v[4];
#pragma unroll
                for (int j = 0; j < 4; ++j) v[j] = *(const LAS f32x4*)(ringp + (r & 3) * 4096 + j * 1024 + lane * 16);
                asm volatile("s_waitcnt lgkmcnt(0)" ::: "memory");
#pragma unroll
                for (int j = 0; j < 4; ++j) asm volatile("" : "+v"(v[j]));
                if (r + 4 < nr) XISSUE(r + 4);
                float s = 0.f;
#pragma unroll
                for (int j = 0; j < 4; ++j) s += (v[j].x * v[j].x + v[j].y * v[j].y) + (v[j].z * v[j].z + v[j].w * v[j].w);
                s = wave_sum(s);
                const size_t row = XROW(r);
                if (lane == 0) RS[row] = 1.f / sqrtf(s * (1.f / D) + EPS);
                u32x2* o8 = (u32x2*)(HB + row * D) + lane;
#pragma unroll
                for (int j = 0; j < 4; ++j) { u32x2 w; w.x = cvtpk(v[j].x, v[j].y); w.y = cvtpk(v[j].z, v[j].w); o8[64 * j] = w; }
            }
#undef XROW
#undef XISSUE
        }
        for (int r = gw; r < NMETA; r += NGW) norm_row_to_bf16(meta_tokens + (size_t)r * D, hmb + (size_t)r * D, lane);
    }
    GRID_BAR();

#pragma clang loop unroll(disable)
    for (int layer = 0; layer < DEPTH; ++layer) {
        const float* gl = ng + (size_t)layer * 4 * D;
        const bool has_meta = layer < 2;
        if (layer < 2) {
            {
                PHASE_BEGIN
                const bf16* W = Win_t + (size_t)layer * 3 * D * D;
                if (layer > 0 && bx < 128) META_NR(2 * (layer - 1) + 1, gl - D);
                const bf16* hmbl = (layer == 0) ? hmb : hmbS(2 * (layer - 1) + 1);
                for (int t = bx; t < 128; t += G) {
                    if (t < 64) { const f32x4 acc = meta_tile(hmbl, W, D, 16 * t, red, wave, lane);
                        if (wave == 0) {
#pragma unroll
                            for (int i = 0; i < 4; ++i) bm[(4 * (lane >> 4) + i) * D + 16 * t + (lane & 15)] = (bf16)f2bf(acc[i]); } }
                    else { const int tt = t - 64, n0c = 1024 + 256 * (tt >> 3) + 16 * (tt & 7);
                        const f32x4 ac = meta_tile(hmbl, W, D, n0c, red, wave, lane); const f32x4 ax = meta_tile(hmbl, W, D, n0c + 128, red, wave, lane);
                        if (wave == 0) {
#pragma unroll
                            for (int i = 0; i < 4; ++i) um[(4 * (lane >> 4) + i) * D + 128 * (tt >> 3) + 16 * (tt & 7) + (lane & 15)] = (bf16)f2bf(ac[i] * ax[i]); } }
                }
                __syncthreads();
                pg8::Gemm g{HB, W, M, 3 * D, D, 0, 1}; pg8::StaticOrder So; So.init(M, 3 * D, G, bx);
                pg8::EpiConvIn E{R0, R1, RS};
                pg8::gemm_phase<pg8::EpiConvIn, pg8::StaticOrder, true, true>(lds, g, So, E);
            }
            GRID_BAR();
            {
                PHASE_BEGIN
                const int chunk = tid & 127, rg = tid >> 7, col0 = chunk * 8;
                const float* cw = conv_w + (size_t)layer * 3 * D + col0;
                float w0[8], w1[8], w2[8];
#pragma unroll
                for (int e = 0; e < 8; ++e) { w0[e] = cw[e]; w1[e] = cw[D + e]; w2[e] = cw[2 * D + e]; }
                const unsigned ring0 = (unsigned)(size_t)lds, wpiece = (unsigned)__builtin_amdgcn_readfirstlane((int)((tid >> 6) * 1024));
                for (int cb = vcu; cb < M / 128; cb += G) {
                    const int r0 = cb * 128 + rg * 32;
                    v4u up2, up1;
                    if ((r0 & (S - 1)) == 0) { up2 = *(const v4u*)(um + 14 * D + col0); up1 = *(const v4u*)(um + 15 * D + col0); }
                    else { up2 = *(const v4u*)(R1 + (size_t)(r0 - 2) * D + col0); up1 = *(const v4u*)(R1 + (size_t)(r0 - 1) * D + col0); }
                    float p2[8], p1[8]; unpack8(up2, p2); unpack8(up1, p1);
#pragma unroll
                    for (int e = 0; e < 8; ++e) { asm volatile("" : "+v"(p2[e])); asm volatile("" : "+v"(p1[e])); }
                    const bf16* usrc = R1 + (size_t)r0 * D + col0; const bf16* bsrc = R0 + (size_t)r0 * D + col0; bf16* vdst = R2 + (size_t)r0 * D + col0;
#pragma unroll
                    for (int k = 0; k < 8; ++k) { glds16(usrc + (size_t)k * D, ring0 + k * 16384 + wpiece); glds16(bsrc + (size_t)k * D, ring0 + k * 16384 + 8192 + wpiece); }
#pragma unroll
                    for (int k = 0; k < 32; ++k) {
                        if (k <= 24) asm volatile("s_waitcnt vmcnt(14)" ::: "memory");
                        else if (k == 25) asm volatile("s_waitcnt vmcnt(12)" ::: "memory");
                        else if (k == 26) asm volatile("s_waitcnt vmcnt(10)" ::: "memory");
                        else if (k == 27) asm volatile("s_waitcnt vmcnt(8)" ::: "memory");
                        else if (k == 28) asm volatile("s_waitcnt vmcnt(6)" ::: "memory");
                        else if (k == 29) asm volatile("s_waitcnt vmcnt(4)" ::: "memory");
                        else if (k == 30) asm volatile("s_waitcnt vmcnt(2)" ::: "memory");
                        else asm volatile("s_waitcnt vmcnt(0)" ::: "memory");
                        const v4u uw = *(const LAS v4u*)(lds + (k & 7) * 16384 + tid * 16), bw = *(const LAS v4u*)(lds + (k & 7) * 16384 + 8192 + tid * 16);
                        float u[8], bb[8], v[8]; unpack8(uw, u); unpack8(bw, bb);
                        asm volatile("s_waitcnt lgkmcnt(0)" ::: "memory");
                        if (k + 8 < 32) { glds16(usrc + (size_t)(k + 8) * D, ring0 + (k & 7) * 16384 + wpiece); glds16(bsrc + (size_t)(k + 8) * D, ring0 + (k & 7) * 16384 + 8192 + wpiece); }
#pragma unroll
                        for (int e = 0; e < 8; ++e) { v[e] = bb[e] * (w0[e] * p2[e] + w1[e] * p1[e] + w2[e] * u[e]); p2[e] = p1[e]; p1[e] = u[e]; }
                        v4u o; o.x = cvtpk(v[0], v[1]); o.y = cvtpk(v[2], v[3]); o.z = cvtpk(v[4], v[5]); o.w = cvtpk(v[6], v[7]);
                        *(v4u*)(vdst + (size_t)k * D) = o;
                    }
                }
                const int gt = vcu * (NWAVES * 64) + tid;
                if (gt < NMETA * 128) {
                    const int t = gt >> 7, c0 = (gt & 127) * 8; const float* cwm = conv_w + (size_t)layer * 3 * D + c0;
                    float u0[8], u1[8], u2[8], bb[8];
                    unpack8(*(const v4u*)(um + t * D + c0), u2); unpack8(*(const v4u*)(bm + t * D + c0), bb);
                    unpack8(*(const v4u*)(um + (t >= 1 ? t - 1 : 0) * D + c0), u1); unpack8(*(const v4u*)(um + (t >= 2 ? t - 2 : 0) * D + c0), u0);
                    const float f1 = t >= 1 ? 1.f : 0.f, f0 = t >= 2 ? 1.f : 0.f;
                    float v[8];
#pragma unroll
                    for (int e = 0; e < 8; ++e) v[e] = bb[e] * (cwm[e] * (u0[e] * f0) + cwm[D + e] * (u1[e] * f1) + cwm[2 * D + e] * u2[e]);
                    v4u o; o.x = cvtpk(v[0], v[1]); o.y = cvtpk(v[2], v[3]); o.z = cvtpk(v[4], v[5]); o.w = cvtpk(v[6], v[7]);
                    *(v4u*)(vm + t * D + c0) = o;
                }
                { LAS float* gl_lds = (LAS float*)(lds + RING_BYTES + 10240); for (int i = tid; i < D; i += NWAVES * 64) gl_lds[i] = gl[D + i]; }
            }
            GRID_BAR();
        } else {
            if (layer == 2) {
                PHASE_BEGIN
                if (bx < 128) META_NR(3, gl - D);
                for (int t = bx; t < 128; t += G) {
                    if (t < 64) { const f32x4 acc = meta_tile(hmbS(3), Wqk_t + (size_t)D * D, D, 16 * t, red, wave, lane);
                        if (wave == 0) {
#pragma unroll
                            for (int i = 0; i < 4; ++i) km[(4 * (lane >> 4) + i) * D + 16 * t + (lane & 15)] = (bf16)f2bf(acc[i]); } }
                    else { const int tt = t - 64; const f32x4 acc = meta_tile(hmbS(3), Wv_t, D, 16 * tt, red, wave, lane);
                        if (wave == 0) {
#pragma unroll
                            for (int i = 0; i < 4; ++i) vtm[(16 * tt + (lane & 15)) * NMETA + 4 * (lane >> 4) + i] = (bf16)f2bf(acc[i]); } }
                }
                __syncthreads();
                { pg8::Gemm g{HB, Wqk_t, M, 2 * D, D, 0, 1}; pg8::StaticOrder So; So.init(M, 2 * D, G, bx);
                  pg8::EpiPlain E{R1, D, D, ((long)WS_K - (long)WS_R1) / 2, RS, nullptr};
                  pg8::gemm_phase<pg8::EpiPlain, pg8::StaticOrder, true, true>(lds, g, So, E); }
                __syncthreads();
                { pg8::Gemm g{Wv_t, HB, D, M, D, 1, 0}; pg8::StaticOrder So; So.init(D, M, G, bx);
                  pg8::EpiPlain E{VT, M, 0, 0, nullptr, RS};
                  pg8::gemm_phase<pg8::EpiPlain, pg8::StaticOrder, true, true>(lds, g, So, E); }
            } else {
                PHASE_BEGIN
                pg8::Gemm g{HB, Wq3_t, M, D, D, 0, 1}; pg8::StaticOrder So; So.init(M, D, G, bx);
                pg8::EpiPlain E{R1, D, 0, 0, RS, nullptr};
                pg8::gemm_phase<pg8::EpiPlain, pg8::StaticOrder, true, true>(lds, g, So, E);
            }
            GRID_BAR();
            { PHASE_BEGIN
            attn_phase(lds, R1, KB, VT, km, vtm, R1, vcu, G, wave, lane);
            { LAS float* gl_lds = (LAS float*)(lds + RING_BYTES + 10240); for (int i = tid; i < D; i += NWAVES * 64) gl_lds[i] = gl[D + i]; }
            }
            GRID_BAR();
        }
        {
            PHASE_BEGIN
            const bf16* Wm = (layer < 2) ? (Wout_t + (size_t)layer * D * D) : (Wo_t + (size_t)(layer - 2) * D * D);
            const bf16* Am = (layer < 2) ? R2 : R1;
            if (has_meta) {
                for (int t = bx; t < 64; t += G) { const f32x4 acc = meta_tile(vm, Wm, D, 16 * t, red, wave, lane);
                    if (wave == 0) {
#pragma unroll
                        for (int i = 0; i < 4; ++i) ym[(4 * (lane >> 4) + i) * D + 16 * t + (lane & 15)] = (bf16)f2bf(acc[i]); } }
                __syncthreads();
            }
            pg8::Gemm g{Am, Wm, M, D, D, 0, 1}; pg8::StaticOrder So; So.init(M, D, G, bx);
            pg8::EpiNormRes<false> E{HB, HB, nullptr, gl + D, RS, (float*)(ws + WS_SQP), (unsigned*)(ws + WS_CNT) + (size_t)(2 * layer) * 128 * 4 * 16, (unsigned long long*)(ws + WS_GRAN), (unsigned)(2 * layer + 1), nullptr,
                                     (LAS float*)(lds + RING_BYTES + 2048), (LAS float*)(lds + RING_BYTES + 6144), (LAS float*)(lds + RING_BYTES + 1024), (const LAS float*)(lds + RING_BYTES + 10240)};
            pg8::gemm_phase<pg8::EpiNormRes<false>, pg8::StaticOrder, true, true>(lds, g, So, E);
        }
        GRID_BAR();
        const int nhalf = (layer == 2) ? 2 : 1;
#pragma clang loop unroll(disable)
        for (int half = 0; half < nhalf; ++half) {
            const int Mh = M / nhalf; const size_t roff = (size_t)half * Mh;
            {
                PHASE_BEGIN
                const bf16* W1l = W1_t + (size_t)layer * FF * D; bf16* Fb = (layer != 2) ? KB : R1;
                if (has_meta && half == 0) {
                    META_NR(2 * layer, gl + D);
                    for (int t = bx; t < 256; t += G) { const f32x4 acc = meta_tile(hmbS(2 * layer), W1l, D, 16 * t, red, wave, lane);
                        if (wave == 0) {
#pragma unroll
                            for (int i = 0; i < 4; ++i) { const float a = fmaxf(acc[i], 0.f); fm[(4 * (lane >> 4) + i) * FF + 16 * t + (lane & 15)] = (bf16)f2bf(a * a); } } }
                    __syncthreads();
                }
                pg8::Gemm g{HB + roff * D, W1l, Mh, FF, D, 0, 1}; pg8::StaticOrder So; So.init(Mh, FF, G, bx);
                pg8::EpiRelu2Raw E{Fb, FF};
                pg8::gemm_phase<pg8::EpiRelu2Raw, pg8::StaticOrder, true, true>(lds, g, So, E);
                { LAS float* gl_lds = (LAS float*)(lds + RING_BYTES + 10240); for (int i = tid; i < D; i += NWAVES * 64) gl_lds[i] = gl[3 * D + i]; }
            }
            GRID_BAR();
            {
                PHASE_BEGIN
                const bf16* W2l = W2_t + (size_t)layer * D * FF; const bf16* Fb = (layer != 2) ? KB : R1;
                if (has_meta && half == 0) {
                    for (int t = bx; t < 64; t += G) { const f32x4 acc = meta_tile(fm, W2l, FF, 16 * t, red, wave, lane);
                        if (wave == 0) {
#pragma unroll
                            for (int i = 0; i < 4; ++i) ym[(4 * (lane >> 4) + i) * D + 16 * t + (lane & 15)] = (bf16)f2bf(acc[i]); } }
                    __syncthreads();
                }
                pg8::Gemm g{Fb, W2l, Mh, D, FF, 1, 1}; pg8::StaticOrder So; So.init(Mh, D, G, bx);
                unsigned long long* granp = (unsigned long long*)(ws + WS_GRAN) + roff; const unsigned tagp = (unsigned)(2 * layer + 2);
                float* sqp = (float*)(ws + WS_SQP) + roff; unsigned* cntp = (unsigned*)(ws + WS_CNT) + ((size_t)(2 * layer + 1) * 128 + roff / 256) * 4 * 16;
                LAS float* xa = (LAS float*)(lds + RING_BYTES + 2048); LAS float* xb = (LAS float*)(lds + RING_BYTES + 6144); LAS float* sarr = (LAS float*)(lds + RING_BYTES + 1024);
                if (layer == DEPTH - 1) {
                    pg8::EpiNormRes<true> E{HB + roff * D, nullptr, out + roff * D, gl + 3 * D, nullptr, sqp, cntp, granp, tagp, RS + roff, xa, xb, sarr, (const LAS float*)(lds + RING_BYTES + 10240)};
                    pg8::gemm_phase<pg8::EpiNormRes<true>, pg8::StaticOrder, true, true>(lds, g, So, E);
                } else {
                    pg8::EpiNormRes<false> E{HB + roff * D, HB + roff * D, nullptr, gl + 3 * D, RS + roff, sqp, cntp, granp, tagp, RS + roff, xa, xb, sarr, (const LAS float*)(lds + RING_BYTES + 10240)};
                    pg8::gemm_phase<pg8::EpiNormRes<false>, pg8::StaticOrder, true, true>(lds, g, So, E);
                }
            }
            if (!(layer == DEPTH - 1 && half == nhalf - 1)) GRID_BAR();
        }
    }
#undef GRID_BAR
#undef PHASE_BEGIN
#undef Win_t
#undef Wout_t
#undef Wqk_t
#undef Wv_t
#undef Wq3_t
#undef Wo_t
#undef W1_t
#undef W2_t
#undef HB
#undef KB
#undef VT
#undef R0
#undef R1
#undef R2
#undef hmS
#undef hmbS
#undef META_NR
#undef hmb
#undef bm
#undef um
#undef vm
#undef ym
#undef fm
#undef km
#undef vtm
#undef RS
}

extern "C" void kernel_launch(void* const* d_in, const int* in_sizes, int n_in, void* d_out, int out_size, void* d_ws, size_t ws_size, hipStream_t stream) {
    static int grid = 0;
    if (grid == 0) {
        if (n_in != 13 || in_sizes[0] != M * D || out_size != M * D || ws_size < WS_END) { fprintf(stderr, "kernel_launch: unexpected shapes (n_in %d, in0 %d, out %d, ws %zu); nothing launched\n", n_in, n_in > 0 ? in_sizes[0] : -1, out_size, ws_size); grid = -1; return; }
        int dev = 0, cus = 0, per_cu = 0;
        if (hipGetDevice(&dev) != hipSuccess || hipDeviceGetAttribute(&cus, hipDeviceAttributeMultiprocessorCount, dev) != hipSuccess) { grid = -1; return; }
        if (hipFuncSetAttribute((const void*)yoco_fwd, hipFuncAttributeMaxDynamicSharedMemorySize, LDS_BYTES) != hipSuccess) { fprintf(stderr, "kernel_launch: hipFuncSetAttribute failed\n"); grid = -1; return; }
        if (hipOccupancyMaxActiveBlocksPerMultiprocessor(&per_cu, (const void*)yoco_fwd, NWAVES * 64, LDS_BYTES) != hipSuccess || per_cu < 1)
            fprintf(stderr, "kernel_launch: note: occupancy query reports %d workgroups per CU\n", per_cu);
        (void)hipGetLastError();
        if (cus < 200) { fprintf(stderr, "kernel_launch: %d CUs: the epilogue exchange needs its four partner units within one round\n", cus); grid = -1; return; }
        grid = cus;
    }
    if (grid < 0) return;
    if (hipMemsetAsync((char*)d_ws + WS_CTL, 0, CTL_ZERO_BYTES, stream) != hipSuccess) return;
    Args a{};
    for (int i = 0; i < 13; ++i) a.in[i] = (const float*)d_in[i];
    a.out = (float*)d_out; a.ws = (unsigned char*)d_ws;
    hipLaunchKernelGGL(yoco_fwd, dim3(grid), dim3(NWAVES * 64), LDS_BYTES, stream, a);
}
```

```cpp
#include <hip/hip_runtime.h>
#include <cstdio>
#include <cstdint>

namespace pg8 {
#define PG8_LAS __attribute__((address_space(3)))
typedef unsigned short bf16_t;
typedef short bf16x8 __attribute__((ext_vector_type(8)));
typedef float f32x4 __attribute__((ext_vector_type(4)));
typedef unsigned u32x4 __attribute__((ext_vector_type(4)));
constexpr int BM = 256, BK = 64, HALF = 128, HTB = HALF * BK * 2  , STAGE_BYTES = 8 * HTB, NXCD = 8, WGM = 8;

__host__ __device__ __forceinline__ int lds_byte(int r, int c) { const int st = (r >> 4) * 2 + (c >> 5), rr = r & 15, cc = c & 31, ob = rr * 64 + cc * 2; return st * 1024 + (ob ^ (((ob >> 9) & 1) << 5)); }
__host__ __device__ __forceinline__ void stage_rc(int b, int& R, int& C) { const int st = b / 1024, sb = b % 1024, swz = sb ^ (((sb >> 9) & 1) << 5); R = (st >> 1) * 16 + swz / 64; C = (st & 1) * 32 + (swz % 64) / 2; }
__host__ __device__ __forceinline__ int perm32(int rho) { const int n = rho >> 4, i = rho & 15; return 8 * (i >> 2) + 4 * n + (i & 3); }

struct Unit { int pm, pn; };
struct Gemm { const bf16_t* A; const bf16_t* Bt; int M, N, K; int ablk = 0, bblk = 0; };

struct StaticOrder {
    int nM, nN, nwg, G, c;
    __host__ __device__ void init(int M, int N, int G_, int c_) { nM = M / BM; nN = N / BM; nwg = nM * nN; G = G_; c = c_; }
    __host__ __device__ bool next(int i, Unit& u) const {
        const long L = (long)i * G + c; if (L >= nwg) return false;
        int wgid = (int)L; { const int q = nwg / NXCD, r = nwg % NXCD, xcd = wgid % NXCD, off = wgid / NXCD; wgid = (xcd < r ? xcd * (q + 1) : r * (q + 1) + (xcd - r) * q) + off; }
        const int nig = WGM * nN, gid = wgid / nig, fm = gid * WGM, gsz = (nM - fm) < WGM ? (nM - fm) : WGM;
        u.pm = fm + ((wgid % nig) % gsz); u.pn = (wgid % nig) / gsz; return true;
    }
    __device__ __forceinline__ void a_ready(const Unit&) const {}
    __device__ __forceinline__ void done(const Unit&) const {}
};

__device__ __forceinline__ unsigned cvt_pk_bf16(float lo, float hi) { unsigned r; asm volatile("v_cvt_pk_bf16_f32 %0, %1, %2" : "=v"(r) : "v"(lo), "v"(hi)); return r; }
__device__ __forceinline__ u32x4 pack8(const f32x4 v0, const f32x4 v1) { u32x4 w; w.x = cvt_pk_bf16(v0[0], v0[1]); w.y = cvt_pk_bf16(v0[2], v0[3]); w.z = cvt_pk_bf16(v1[0], v1[1]); w.w = cvt_pk_bf16(v1[2], v1[3]); return w; }
struct EpiPlain {
    static constexpr bool PERM = true, AFTER_DRAIN = false, PREFETCH = false;
    bf16_t* O; int ldc; int split_cols; long split_stride; const float* rs_row; const float* rs_col;
    __device__ __forceinline__ void operator()(const f32x4 (&acc)[2][2][4][2], const Unit& u, int wr, int wc, int fr, int fq) const {
        const int row0 = u.pm * BM + wr * 64 + fr; int colt = u.pn * BM; bf16_t* base = O;
        if (split_cols) { const int t = colt / split_cols; base += (long)t * split_stride; colt -= t * split_cols; }
        const int col0 = colt + wc * 32 + 8 * fq;
        f32x4 cs[2][2];
#pragma unroll
        for (int bj = 0; bj < 2; ++bj)
#pragma unroll
            for (int n = 0; n < 2; ++n) cs[bj][n] = rs_col ? *(const f32x4*)(rs_col + u.pn * BM + wc * 32 + 8 * fq + bj * HALF + 4 * n) : (f32x4){1.f, 1.f, 1.f, 1.f};
        float srv[2][4];
#pragma unroll
        for (int ai = 0; ai < 2; ++ai)
#pragma unroll
            for (int m = 0; m < 4; ++m) srv[ai][m] = rs_row ? rs_row[row0 + ai * HALF + m * 16] : 1.f;
#pragma unroll
        for (int ai = 0; ai < 2; ++ai)
#pragma unroll
            for (int m = 0; m < 4; ++m) { const int r = row0 + ai * HALF + m * 16; bf16_t* rowp = base + (size_t)r * ldc + col0; const float sr = srv[ai][m];
#pragma unroll
                for (int bj = 0; bj < 2; ++bj) *(u32x4*)(rowp + bj * HALF) = pack8(acc[ai][bj][m][0] * (cs[bj][0] * sr), acc[ai][bj][m][1] * (cs[bj][1] * sr)); }
    }
};
struct EpiRelu2 {
    static constexpr bool PERM = true, AFTER_DRAIN = false, PREFETCH = false;
    bf16_t* O; int ldc; const float* rs;
    __device__ __forceinline__ void operator()(const f32x4 (&acc)[2][2][4][2], const Unit& u, int wr, int wc, int fr, int fq) const {
        const int row0 = u.pm * BM + wr * 64 + fr; const int col0 = u.pn * BM + wc * 32 + 8 * fq;
        float srv[2][4];
#pragma unroll
        for (int ai = 0; ai < 2; ++ai)
#pragma unroll
            for (int m = 0; m < 4; ++m) srv[ai][m] = rs[row0 + ai * HALF + m * 16];
#pragma unroll
        for (int ai = 0; ai < 2; ++ai)
#pragma unroll
            for (int m = 0; m < 4; ++m) { const int r = row0 + ai * HALF + m * 16; bf16_t* rowp = O + (size_t)r * ldc + col0; const float sr = srv[ai][m];
#pragma unroll
                for (int bj = 0; bj < 2; ++bj) { f32x4 v0 = acc[ai][bj][m][0], v1 = acc[ai][bj][m][1];
#pragma unroll
                    for (int e = 0; e < 4; ++e) { const float a = fmaxf(v0[e], 0.f) * sr, b = fmaxf(v1[e], 0.f) * sr; v0[e] = a * a; v1[e] = b * b; }
                    *(u32x4*)(rowp + bj * HALF) = pack8(v0, v1); } }
    }
};
__device__ __forceinline__ float relu1(float v) { float m; asm("v_max_f32 %0, 0, %1" : "=v"(m) : "v"(v)); return m; }
struct EpiRelu2Raw {
    static constexpr bool PERM = true, AFTER_DRAIN = false, PREFETCH = false;
    bf16_t* O; int ldc;
    __device__ __forceinline__ void operator()(const f32x4 (&acc)[2][2][4][2], const Unit& u, int wr, int wc, int fr, int fq) const {
        const int row0 = u.pm * BM + wr * 64 + fr; const int col0 = u.pn * BM + wc * 32 + 8 * fq;
#pragma unroll
        for (int ai = 0; ai < 2; ++ai)
#pragma unroll
            for (int m = 0; m < 4; ++m) { const int rl = wr * 64 + fr + ai * HALF + m * 16;
                bf16_t* rowp = O + (size_t)u.pm * BM * ldc + (size_t)(col0 >> 6) * (BM * BK) + rl * BK + (col0 & 63);
#pragma unroll
                for (int bj = 0; bj < 2; ++bj) { const f32x4 a0 = acc[ai][bj][m][0], a1 = acc[ai][bj][m][1];
                    const f32x4 m0 = {relu1(a0[0]), relu1(a0[1]), relu1(a0[2]), relu1(a0[3])}, m1 = {relu1(a1[0]), relu1(a1[1]), relu1(a1[2]), relu1(a1[3])};
                    *(u32x4*)(rowp + bj * 2 * (BM * BK)) = pack8(m0 * m0, m1 * m1); }
                __builtin_amdgcn_sched_barrier(0); }
    }
};
struct EpiConvIn {
    static constexpr bool PERM = true, AFTER_DRAIN = false, PREFETCH = false;
    bf16_t* Bo; bf16_t* Uo; const float* rs;
    __device__ __forceinline__ void operator()(const f32x4 (&acc)[2][2][4][2], const Unit& u, int wr, int wc, int fr, int fq) const {
        const int row0 = u.pm * BM + wr * 64 + fr;
        float srv[2][4];
#pragma unroll
        for (int ai = 0; ai < 2; ++ai)
#pragma unroll
            for (int m = 0; m < 4; ++m) srv[ai][m] = rs[row0 + ai * HALF + m * 16];
        if (u.pn < 4) {
            const int col0 = u.pn * BM + wc * 32 + 8 * fq;
#pragma unroll
            for (int ai = 0; ai < 2; ++ai)
#pragma unroll
                for (int m = 0; m < 4; ++m) { const int r = row0 + ai * HALF + m * 16; bf16_t* rowp = Bo + (size_t)r * 1024 + col0; const float sr = srv[ai][m];
#pragma unroll
                    for (int bj = 0; bj < 2; ++bj) *(u32x4*)(rowp + bj * HALF) = pack8(acc[ai][bj][m][0] * sr, acc[ai][bj][m][1] * sr); }
        } else {
            const int col0 = (u.pn - 4) * HALF + wc * 32 + 8 * fq;
#pragma unroll
            for (int ai = 0; ai < 2; ++ai)
#pragma unroll
                for (int m = 0; m < 4; ++m) { const int r = row0 + ai * HALF + m * 16; bf16_t* rowp = Uo + (size_t)r * 1024 + col0; const float sr = srv[ai][m], s2 = sr * sr;
                    *(u32x4*)rowp = pack8(acc[ai][0][m][0] * acc[ai][1][m][0] * s2, acc[ai][0][m][1] * acc[ai][1][m][1] * s2); }
        }
    }
};

constexpr int NR_ROWS = 32768;
#define PG8_GAS __attribute__((address_space(1)))
#define PG8_RLX_AGENT __ATOMIC_RELAXED, __HIP_MEMORY_SCOPE_AGENT
template <bool F32OUT>
struct EpiNormRes {
    static constexpr bool PERM = true, AFTER_DRAIN = false, PREFETCH = false;
    const bf16_t* Hin; bf16_t* Hout; float* Fout;
    const float* gain; float* rs_out;
    float* sq_part; unsigned* cnt;
    unsigned long long* gran; unsigned tag;
    const float* ys;
    PG8_LAS float* xa; PG8_LAS float* xb; PG8_LAS float* sarr;
    const PG8_LAS float* glds;
    __device__ __forceinline__ void operator()(const f32x4 (&acc)[2][2][4][2], const Unit& u, int wr, int wc, int fr_in, int fq_in) const {
        int fr = fr_in, fq = fq_in; asm volatile("" : "+v"(fr), "+v"(fq));
        const int rl0 = wr * 64 + fr, wid = wr * 4 + wc, lane = fr + 16 * fq;
        const size_t row0 = (size_t)u.pm * BM + rl0; const int col0 = u.pn * BM + wc * 32 + 8 * fq;
        u32x4 yb[2][4][2];
#pragma unroll
        for (int ai = 0; ai < 2; ++ai)
#pragma unroll
            for (int m = 0; m < 4; ++m)
#pragma unroll
                for (int bj = 0; bj < 2; ++bj) yb[ai][m][bj] = pack8(acc[ai][bj][m][0], acc[ai][bj][m][1]);
        __builtin_amdgcn_sched_barrier(0);
        u32x4 hv[2][4][2];
#pragma unroll
        for (int ai = 0; ai < 2; ++ai)
#pragma unroll
            for (int m = 0; m < 4; ++m)
#pragma unroll
                for (int bj = 0; bj < 2; ++bj) hv[ai][m][bj] = *(const u32x4*)(Hin + (row0 + ai * HALF + m * 16) * 1024 + col0 + bj * HALF);
        __builtin_amdgcn_sched_barrier(0);
#pragma unroll
        for (int ai = 0; ai < 2; ++ai)
#pragma unroll
            for (int m = 0; m < 4; ++m) { f32x4 q = {0.f, 0.f, 0.f, 0.f};
#pragma unroll
                for (int bj = 0; bj < 2; ++bj) { const u32x4 yw = yb[ai][m][bj];
                    const f32x4 y0 = {__uint_as_float(yw.x << 16), __uint_as_float(yw.x & 0xffff0000u), __uint_as_float(yw.y << 16), __uint_as_float(yw.y & 0xffff0000u)},
                                y1 = {__uint_as_float(yw.z << 16), __uint_as_float(yw.z & 0xffff0000u), __uint_as_float(yw.w << 16), __uint_as_float(yw.w & 0xffff0000u)};
                    q += y0 * y0; q += y1 * y1; }
                float p = (q[0] + q[1]) + (q[2] + q[3]); p += __shfl_xor(p, 16); p += __shfl_xor(p, 32);
                if (fq == 0) xa[(rl0 + ai * HALF + m * 16) * 4 + wc] = p; }
#pragma unroll
        for (int ai = 0; ai < 2; ++ai)
#pragma unroll
            for (int m = 0; m < 4; ++m)
#pragma unroll
                for (int bj = 0; bj < 2; ++bj) asm volatile("" : "+v"(yb[ai][m][bj]));
        asm volatile("s_waitcnt lgkmcnt(0)" ::: "memory");
        __builtin_amdgcn_s_barrier();
        if (wid < 4) {
            const int t = wid * 64 + lane;
            const size_t grow = (size_t)u.pm * BM + t;
            float y2 = ys ? ys[grow] : 1.f; y2 *= y2;
            const f32x4 v = *(const PG8_LAS f32x4*)(xa + t * 4);
            const float own = (((v[0] + v[1]) + v[2]) + v[3]) * (y2 * y2);
            PG8_GAS unsigned long long* gp = (PG8_GAS unsigned long long*)gran + grow;
            __hip_atomic_store(gp + (size_t)u.pn * NR_ROWS, ((unsigned long long)tag << 32) | __float_as_uint(own), PG8_RLX_AGENT);
            unsigned long long g0, g1, g2, g3;
            for (unsigned spins = 0;;) {
                g0 = __hip_atomic_load(gp, PG8_RLX_AGENT); g1 = __hip_atomic_load(gp + NR_ROWS, PG8_RLX_AGENT); g2 = __hip_atomic_load(gp + 2 * NR_ROWS, PG8_RLX_AGENT); g3 = __hip_atomic_load(gp + 3 * NR_ROWS, PG8_RLX_AGENT);
                const bool ok = (unsigned)(g0 >> 32) == tag && (unsigned)(g1 >> 32) == tag && (unsigned)(g2 >> 32) == tag && (unsigned)(g3 >> 32) == tag;
                if (__all(ok)) break;
                __builtin_amdgcn_s_sleep(1);
                if (++spins > (1u << 20)) break;
            }
            const float tot = ((__uint_as_float((unsigned)g0) + __uint_as_float((unsigned)g1)) + __uint_as_float((unsigned)g2)) + __uint_as_float((unsigned)g3);
            sarr[t] = y2 / sqrtf(tot * (1.f / 1024.f) + 1e-6f);
        }
        asm volatile("s_waitcnt lgkmcnt(0)" ::: "memory");
        __builtin_amdgcn_s_barrier();
        f32x4 gv[2][2];
#pragma unroll
        for (int bj = 0; bj < 2; ++bj)
#pragma unroll
            for (int n = 0; n < 2; ++n) gv[bj][n] = *(const PG8_LAS f32x4*)(glds + col0 + bj * HALF + 4 * n);
        float sv[2][4];
#pragma unroll
        for (int ai = 0; ai < 2; ++ai)
#pragma unroll
            for (int m = 0; m < 4; ++m) sv[ai][m] = sarr[rl0 + ai * HALF + m * 16];
#pragma unroll
        for (int ai = 0; ai < 2; ++ai)
#pragma unroll
            for (int m = 0; m < 4; ++m) { const float s = sv[ai][m]; const size_t off = (row0 + ai * HALF + m * 16) * 1024 + col0; f32x4 q = {0.f, 0.f, 0.f, 0.f};
#pragma unroll
                for (int bj = 0; bj < 2; ++bj) { const u32x4 h = hv[ai][m][bj], yw = yb[ai][m][bj];
                    const f32x4 h0 = {__uint_as_float(h.x << 16), __uint_as_float(h.x & 0xffff0000u), __uint_as_float(h.y << 16), __uint_as_float(h.y & 0xffff0000u)},
                                h1 = {__uint_as_float(h.z << 16), __uint_as_float(h.z & 0xffff0000u), __uint_as_float(h.w << 16), __uint_as_float(h.w & 0xffff0000u)},
                                y0 = {__uint_as_float(yw.x << 16), __uint_as_float(yw.x & 0xffff0000u), __uint_as_float(yw.y << 16), __uint_as_float(yw.y & 0xffff0000u)},
                                y1 = {__uint_as_float(yw.z << 16), __uint_as_float(yw.z & 0xffff0000u), __uint_as_float(yw.w << 16), __uint_as_float(yw.w & 0xffff0000u)};
                    const f32x4 v0 = h0 + (y0 * s) * gv[bj][0], v1 = h1 + (y1 * s) * gv[bj][1];
                    if constexpr (F32OUT) { *(f32x4*)(Fout + off + bj * HALF) = v0; *(f32x4*)(Fout + off + bj * HALF + 4) = v1; }
                    else { *(u32x4*)(Hout + off + bj * HALF) = pack8(v0, v1); q += v0 * v0; q += v1 * v1; } }
                if constexpr (!F32OUT) { float p = (q[0] + q[1]) + (q[2] + q[3]); p += __shfl_xor(p, 16); p += __shfl_xor(p, 32); if (fq == 0) xb[(rl0 + ai * HALF + m * 16) * 4 + wc] = p; }
                __builtin_amdgcn_sched_barrier(0); }
        if constexpr (!F32OUT) {
            asm volatile("s_waitcnt lgkmcnt(0)" ::: "memory");
            __builtin_amdgcn_s_barrier();
            if (wid < 4) { const int t = wid * 64 + lane; const f32x4 v = *(const PG8_LAS f32x4*)(xb + t * 4);
                const size_t grow = (size_t)u.pm * BM + t;
                PG8_GAS unsigned* sp = (PG8_GAS unsigned*)sq_part + grow;
                __hip_atomic_store(sp + (size_t)u.pn * NR_ROWS, __float_as_uint(((v[0] + v[1]) + v[2]) + v[3]), PG8_RLX_AGENT);
                asm volatile("s_waitcnt vmcnt(0)" ::: "memory");
                unsigned old = 0u;
                if (lane == 0) old = __hip_atomic_fetch_add((PG8_GAS unsigned*)cnt + ((size_t)u.pm * 4 + wid) * 16, 1u, PG8_RLX_AGENT);
                old = (unsigned)__builtin_amdgcn_readfirstlane((int)old);
                if (old == 3u) {
                    __builtin_amdgcn_fence(__ATOMIC_ACQUIRE, "agent");
                    const float q0 = __uint_as_float(__hip_atomic_load(sp, PG8_RLX_AGENT)), q1 = __uint_as_float(__hip_atomic_load(sp + NR_ROWS, PG8_RLX_AGENT)),
                                q2 = __uint_as_float(__hip_atomic_load(sp + 2 * NR_ROWS, PG8_RLX_AGENT)), q3 = __uint_as_float(__hip_atomic_load(sp + 3 * NR_ROWS, PG8_RLX_AGENT));
                    rs_out[grow] = 1.f / sqrtf((((q0 + q1) + q2) + q3) * (1.f / 1024.f) + 1e-6f);
                } }
        }
    }
};
template <class Epi, class Sched, bool ALIGN_EPI = false, bool SP2 = false>
__device__ __forceinline__ void gemm_phase(PG8_LAS unsigned char* lds, const Gemm g, const Sched& S, const Epi& E) {
    int tid_ = threadIdx.x; asm volatile("" : "+v"(tid_));
    const int tid = tid_, wid = __builtin_amdgcn_readfirstlane(tid >> 6), lane = tid & 63, wr = wid >> 2, wc = wid & 3, fr = lane & 15, fq = lane >> 4;
    const int K = g.K, nt = K / BK;
    unsigned voffA[2], voffB[2];
#pragma unroll
    for (int i = 0; i < 2; ++i) { int R, C; stage_rc(tid * 16 + i * 8192, R, C); const int Rb = Epi::PERM ? ((R & ~31) + perm32(R & 31)) : R;
        voffA[i] = (unsigned)(R * (g.ablk ? BK : K) + C) * 2u; voffB[i] = (unsigned)(Rb * (g.bblk ? BK : K) + C) * 2u; }
    const size_t kstep = (size_t)(BK * 2);
    const size_t hstep = (size_t)HALF * K * 2;
    const size_t tstep = 2 * hstep;
    const size_t kstepA = g.ablk ? (size_t)BM * BK * 2 : kstep, hstepA = g.ablk ? (size_t)HALF * BK * 2 : hstep, kstepB = g.bblk ? (size_t)BM * BK * 2 : kstep, hstepB = g.bblk ? (size_t)HALF * BK * 2 : hstep;
    const unsigned ldsw = (unsigned)wid * 1024u;
    const int aoff = lds_byte(wr * 64 + fr, fq * 8), boff = lds_byte(wc * 32 + fr, fq * 8);
#define PG8_SA(b, h) (((b) * 2 + (h)) * HTB)
#define PG8_SB(b, h) ((4 + (b) * 2 + (h)) * HTB)
#define PG8_STAGE(bufoff, gbase, voff) do { _Pragma("unroll") for (int _i = 0; _i < 2; ++_i) \
        __builtin_amdgcn_global_load_lds((const unsigned*)((const char*)(gbase) + (voff)[_i]), (PG8_LAS unsigned*)(lds + (bufoff) + ldsw + _i * 8192), 16, 0, 0); } while (0)
#define PG8_LDA(dst, b, h) do { _Pragma("unroll") for (int m = 0; m < 4; ++m) _Pragma("unroll") for (int k = 0; k < 2; ++k) dst[m][k] = *(const PG8_LAS bf16x8*)(lds + PG8_SA(b, h) + aoff + m * 2048 + k * 1024); } while (0)
#define PG8_LDB(dst, b, h) do { _Pragma("unroll") for (int n = 0; n < 2; ++n) _Pragma("unroll") for (int k = 0; k < 2; ++k) dst[n][k] = *(const PG8_LAS bf16x8*)(lds + PG8_SB(b, h) + boff + n * 2048 + k * 1024); } while (0)
#define PG8_MMA(ai, bj, At, Bt) do { __builtin_amdgcn_s_setprio(1); _Pragma("unroll") for (int m = 0; m < 4; ++m) _Pragma("unroll") for (int n = 0; n < 2; ++n) _Pragma("unroll") for (int k = 0; k < 2; ++k) \
        acc[ai][bj][m][n] = __builtin_amdgcn_mfma_f32_16x16x32_bf16(Bt[n][k], At[m][k], acc[ai][bj][m][n], 0, 0, 0); __builtin_amdgcn_s_setprio(0); } while (0)
#define PG8_MMA_NP(ai, bj, At, Bt) do { _Pragma("unroll") for (int m = 0; m < 4; ++m) _Pragma("unroll") for (int n = 0; n < 2; ++n) _Pragma("unroll") for (int k = 0; k < 2; ++k) \
        acc[ai][bj][m][n] = __builtin_amdgcn_mfma_f32_16x16x32_bf16(Bt[n][k], At[m][k], acc[ai][bj][m][n], 0, 0, 0); } while (0)
#define PG8_WAIT_V(n) asm volatile("s_waitcnt vmcnt(" #n ")" ::: "memory")
#define PG8_WAIT_L(n) asm volatile("s_waitcnt lgkmcnt(" #n ")" ::: "memory")
#define PG8_BAR __builtin_amdgcn_s_barrier()
#define PG8_SCHED __builtin_amdgcn_sched_barrier(0)
    Unit cur, nxt; int ui = 0;
    if (!S.next(0, cur)) return;
    f32x4 acc[2][2][4][2];
#pragma unroll
    for (int a = 0; a < 2; ++a)
#pragma unroll
        for (int b = 0; b < 2; ++b)
#pragma unroll
            for (int m = 0; m < 4; ++m)
#pragma unroll
                for (int n = 0; n < 2; ++n) acc[a][b][m][n] = (f32x4){0.f, 0.f, 0.f, 0.f};
    bf16x8 At[4][2], B0[2][2], B1[2][2];
    const char* cA = (const char*)g.A + (size_t)cur.pm * tstep; const char* cB = (const char*)g.Bt + (size_t)cur.pn * tstep;
    S.a_ready(cur);
    if constexpr (SP2) {
        PG8_STAGE(PG8_SB(0, 0), cB, voffB); PG8_STAGE(PG8_SB(0, 1), cB + hstepB, voffB); PG8_STAGE(PG8_SA(0, 0), cA, voffA); PG8_STAGE(PG8_SA(0, 1), cA + hstepA, voffA);
        if (wr == 1) PG8_BAR;
        PG8_WAIT_V(2); PG8_BAR;
        PG8_STAGE(PG8_SB(1, 0), cB + kstepB, voffB); PG8_STAGE(PG8_SA(1, 0), cA + kstepA, voffA); PG8_STAGE(PG8_SB(1, 1), cB + hstepB + kstepB, voffB);
        PG8_WAIT_V(6); PG8_BAR;
    } else {
        PG8_STAGE(PG8_SB(0, 0), cB, voffB); PG8_STAGE(PG8_SA(0, 0), cA, voffA); PG8_STAGE(PG8_SB(0, 1), cB + hstepB, voffB); PG8_STAGE(PG8_SA(0, 1), cA + hstepA, voffA);
        if (wr == 1) PG8_BAR;
        PG8_WAIT_V(4); PG8_BAR;
        PG8_STAGE(PG8_SB(1, 0), cB + kstepB, voffB); PG8_STAGE(PG8_SA(1, 0), cA + kstepA, voffA); PG8_STAGE(PG8_SB(1, 1), cB + hstepB + kstepB, voffB);
        PG8_WAIT_V(6); PG8_BAR;
    }
    for (;;) {
        const bool has_next = S.next(ui + 1, nxt);
        const char* nA = has_next ? (const char*)g.A + (size_t)nxt.pm * tstep : cA; const char* nB = has_next ? (const char*)g.Bt + (size_t)nxt.pn * tstep : cB;
        for (int t = 0; t < nt; t += 2) {
            const bool last = (t == nt - 2);
            const char* a1 = cA + (size_t)(t + 1) * kstepA;
            const char* a2 = last ? nA : cA + (size_t)(t + 2) * kstepA; const char* b2 = last ? nB : cB + (size_t)(t + 2) * kstepB;
            const char* a3 = a2 + kstepA; const char* b3 = b2 + kstepB;
            if (last && has_next) S.a_ready(nxt);
            if constexpr (SP2) {
            PG8_LDB(B0, 0, 0); PG8_LDB(B1, 0, 1); PG8_SCHED; PG8_LDA(At, 0, 0); PG8_STAGE(PG8_SA(1, 1), a1 + hstepA, voffA);
            PG8_WAIT_V(8); PG8_WAIT_L(0); __builtin_amdgcn_s_setprio(1); PG8_BAR; PG8_MMA_NP(0, 0, At, B0); PG8_MMA_NP(0, 1, At, B1); __builtin_amdgcn_s_setprio(0); PG8_BAR; PG8_SCHED;
            PG8_LDA(At, 0, 1); PG8_STAGE(PG8_SB(0, 0), b2, voffB); PG8_STAGE(PG8_SB(0, 1), b2 + hstepB, voffB); PG8_STAGE(PG8_SA(0, 0), a2, voffA);
            PG8_WAIT_V(8); PG8_WAIT_L(0); __builtin_amdgcn_s_setprio(1); PG8_BAR; PG8_MMA_NP(1, 0, At, B0); PG8_MMA_NP(1, 1, At, B1); __builtin_amdgcn_s_setprio(0); PG8_BAR; PG8_SCHED;
            PG8_LDB(B0, 1, 0); PG8_LDB(B1, 1, 1); PG8_SCHED; PG8_LDA(At, 1, 0); PG8_STAGE(PG8_SA(0, 1), a2 + hstepA, voffA);
            PG8_WAIT_V(8); PG8_WAIT_L(0); __builtin_amdgcn_s_setprio(1); PG8_BAR; PG8_MMA_NP(0, 0, At, B0); PG8_MMA_NP(0, 1, At, B1); __builtin_amdgcn_s_setprio(0); PG8_BAR; PG8_SCHED;
            PG8_LDA(At, 1, 1); PG8_STAGE(PG8_SB(1, 0), b3, voffB); PG8_STAGE(PG8_SB(1, 1), b3 + hstepB, voffB); PG8_STAGE(PG8_SA(1, 0), a3, voffA);
            PG8_WAIT_V(8); PG8_WAIT_L(0); __builtin_amdgcn_s_setprio(1); PG8_BAR; PG8_MMA_NP(1, 0, At, B0); PG8_MMA_NP(1, 1, At, B1); __builtin_amdgcn_s_setprio(0); PG8_BAR; PG8_SCHED;
            } else {
            PG8_LDB(B0, 0, 0); PG8_SCHED; PG8_LDA(At, 0, 0); PG8_STAGE(PG8_SA(1, 1), a1 + hstepA, voffA);
            PG8_WAIT_L(8); PG8_BAR; PG8_WAIT_L(0); PG8_MMA(0, 0, At, B0); PG8_BAR; PG8_SCHED;
            PG8_LDB(B1, 0, 1); PG8_STAGE(PG8_SB(0, 0), b2, voffB);
            PG8_BAR; PG8_WAIT_L(0); PG8_MMA(0, 1, At, B1); PG8_BAR;
            PG8_LDA(At, 0, 1); PG8_STAGE(PG8_SA(0, 0), a2, voffA);
            PG8_BAR; PG8_WAIT_L(0); PG8_MMA(1, 0, At, B0); PG8_BAR; PG8_SCHED;
            PG8_STAGE(PG8_SB(0, 1), b2 + hstepB, voffB);
            PG8_WAIT_V(6); PG8_BAR; PG8_MMA(1, 1, At, B1); PG8_BAR;
            PG8_LDB(B0, 1, 0); PG8_SCHED; PG8_LDA(At, 1, 0); PG8_STAGE(PG8_SA(0, 1), a2 + hstepA, voffA);
            PG8_WAIT_L(8); PG8_BAR; PG8_WAIT_L(0); PG8_MMA(0, 0, At, B0); PG8_BAR; PG8_SCHED;
            PG8_LDB(B1, 1, 1); PG8_STAGE(PG8_SB(1, 0), b3, voffB);
            PG8_BAR; PG8_WAIT_L(0); PG8_MMA(0, 1, At, B1); PG8_BAR;
            PG8_LDA(At, 1, 1); PG8_STAGE(PG8_SA(1, 0), a3, voffA);
            PG8_BAR; PG8_WAIT_L(0); PG8_MMA(1, 0, At, B0); PG8_BAR; PG8_SCHED;
            PG8_STAGE(PG8_SB(1, 1), b3 + hstepB, voffB);
            PG8_WAIT_V(6); PG8_BAR; PG8_MMA(1, 1, At, B1); PG8_BAR;
            }
        }
        if constexpr (ALIGN_EPI) { if (wr == 0) PG8_BAR; }
        if constexpr (!Epi::AFTER_DRAIN) { E(acc, cur, wr, wc, fr, fq); S.done(cur); }
        if (!has_next) break;
#pragma unroll
        for (int a = 0; a < 2; ++a)
#pragma unroll
            for (int b = 0; b < 2; ++b)
#pragma unroll
                for (int m = 0; m < 4; ++m)
#pragma unroll
                    for (int n = 0; n < 2; ++n) acc[a][b][m][n] = (f32x4){0.f, 0.f, 0.f, 0.f};
        cur = nxt; cA = nA; cB = nB; ++ui;
        if constexpr (ALIGN_EPI) { if (wr == 1) PG8_BAR; }
    }
    PG8_WAIT_V(0);
    if constexpr (!ALIGN_EPI) { if (wr == 0) PG8_BAR; }
    PG8_BAR;
    if constexpr (Epi::AFTER_DRAIN) { E.fused(acc, cur, wr, wc, fr, fq, lds, wid, lane); S.done(cur); }
#undef PG8_SA
#undef PG8_SB
#undef PG8_STAGE
#undef PG8_LDA
#undef PG8_LDB
#undef PG8_MMA
#undef PG8_MMA_NP
#undef PG8_WAIT_V
#undef PG8_WAIT_L
#undef PG8_BAR
#undef PG8_SCHED
}
}
#define GAS __attribute__((address_space(1)))
#define LAS __attribute__((address_space(3)))
typedef unsigned short bf16;
typedef unsigned v4u __attribute__((ext_vector_type(4)));
typedef float f32x4 __attribute__((ext_vector_type(4)));
typedef short bf16x8 __attribute__((ext_vector_type(8)));
typedef GAS unsigned gu32;
typedef GAS unsigned long long gu64;
#define RLX_AGENT __ATOMIC_RELAXED, __HIP_MEMORY_SCOPE_AGENT
#define LDS_WAIT() asm volatile("s_waitcnt lgkmcnt(0)" ::: "memory")
#define VM_WAIT() asm volatile("s_waitcnt vmcnt(0)" ::: "memory")
__device__ __forceinline__ unsigned long long rt() { return __builtin_amdgcn_s_memrealtime(); }
__device__ __forceinline__ unsigned f2bf(float f) { unsigned u = __builtin_bit_cast(unsigned, f); return (u + 0x7fffu + ((u >> 16) & 1u)) >> 16; }
__device__ __forceinline__ unsigned pk2(float lo, float hi) { return f2bf(lo) | (f2bf(hi) << 16); }
#define XB_TMO      128
#define XB_XCNT(j)  (256  + 64 * (j))
#define XB_XSUB(j)  (1280 + 64 * (j))
#define XB_XGEN(j)  (2304 + 64 * (j))
#define XB_TOP      3328
#define XB_TOPGEN   3392
#define XCD_BAR_WORDS 3456
#define XB_SPIN_CAP (1u << 18)

__device__ __forceinline__ unsigned xb_ld(unsigned* p)              { return __hip_atomic_load(p, __ATOMIC_RELAXED, __HIP_MEMORY_SCOPE_AGENT); }
__device__ __forceinline__ unsigned xb_add(unsigned* p, unsigned v) { return __hip_atomic_fetch_add(p, v, __ATOMIC_RELAXED, __HIP_MEMORY_SCOPE_AGENT); }
__device__ __forceinline__ unsigned xb_xcc_id() { return (unsigned)__builtin_amdgcn_s_getreg((3 << 11) | 20) & 0xFu; }
#define XB_SPIN(cond, bar) do { unsigned _sp = 0; while (cond) { __builtin_amdgcn_s_sleep(1); \
    if ((++_sp & 255u) == 0u) { if (xb_ld(&(bar)[XB_TMO])) break; if (_sp > XB_SPIN_CAP) { atomicAdd(&(bar)[XB_TMO], 1u); break; } } } } while (0)

struct XcdBarrier {
    unsigned* bar; unsigned x;
    volatile LAS unsigned* st;
};

__device__ __forceinline__ XcdBarrier xcd_barrier_post(unsigned* bar, volatile LAS unsigned* st) {
    XcdBarrier b; b.bar = bar; b.x = xb_xcc_id(); b.st = st;
    if (threadIdx.x == 0) (void)xb_add(&bar[XB_XCNT(b.x)], 1u);
    return b;
}
__device__ __forceinline__ void xcd_barrier_complete(unsigned* bar, unsigned x, unsigned& nloc, unsigned& nx) {
    const unsigned G = gridDim.x * gridDim.y * gridDim.z;
    unsigned sum, cnt, mine, sp = 0u;
    for (;;) {
        sum = 0u; cnt = 0u; mine = 0u;
#pragma unroll
        for (unsigned j = 0; j < 16; ++j) { const unsigned c = xb_ld(&bar[XB_XCNT(j)]); sum += c; cnt += (c > 0u) ? 1u : 0u; mine = (j == x) ? c : mine; }
        if (sum == G) break;
        __builtin_amdgcn_s_sleep(1);
        if ((++sp & 255u) == 0u) { if (xb_ld(&bar[XB_TMO])) break; if (sp > XB_SPIN_CAP) { atomicAdd(&bar[XB_TMO], 1u); break; } }
    }
    nloc = mine > 0u ? mine : 1u; nx = cnt > 0u ? cnt : 1u;
}

__device__ __forceinline__ void xcd_barrier(const XcdBarrier& b) {
    asm volatile("s_waitcnt vmcnt(0)" ::: "memory");
    __syncthreads();
    if (threadIdx.x == 0) {
        unsigned* bar = b.bar;
        __builtin_amdgcn_s_waitcnt(0);
        unsigned nloc = b.st[0], nx = b.st[1];
        if (nloc == 0u) { xcd_barrier_complete(bar, b.x, nloc, nx); b.st[0] = nloc; b.st[1] = nx; }
        const unsigned old = xb_add(&bar[XB_XSUB(b.x)], 1u);
        const unsigned gen = old / nloc;
        if (nloc >= 4u && old == gen * nloc + nloc / 2u) asm volatile("buffer_wbl2 sc1" ::: "memory");
        if (old + 1u == (gen + 1u) * nloc) {
            __builtin_amdgcn_fence(__ATOMIC_RELEASE, "agent");
            asm volatile("s_waitcnt vmcnt(0)" ::: "memory");
            const unsigned og = xb_add(&bar[XB_TOP], 1u);
            const unsigned tg = og / nx;
            if (og + 1u == (tg + 1u) * nx) xb_add(&bar[XB_TOPGEN], 1u);
            else XB_SPIN(xb_ld(&bar[XB_TOPGEN]) == tg, bar);
            xb_add(&bar[XB_XGEN(b.x)], 1u);
            __builtin_amdgcn_fence(__ATOMIC_ACQUIRE, "agent");
            asm volatile("s_waitcnt vmcnt(0)" ::: "memory");
        } else {
            XB_SPIN(xb_ld(&bar[XB_XGEN(b.x)]) == gen, bar);
            __builtin_amdgcn_fence(__ATOMIC_ACQUIRE, "agent");
            asm volatile("s_waitcnt vmcnt(0)" ::: "memory");
        }
    }
    __syncthreads();
}
constexpr int NB = 4, S = 8192, D = 1024, NH = 16, HD = 64, FF = 4096, NMETA = 16, DEPTH = 4;
constexpr int M = NB * S;
constexpr float EPS = 1e-6f;
constexpr float QSCALE = 0.125f * 1.4426950408889634f;
constexpr float SB_THRESH = 152.f;
constexpr int NWAVES = 8;

constexpr size_t MiB = 1u << 20, KiB = 1u << 10;
constexpr size_t WS_CTL = 480 * MiB, CTL_BAR_BYTES = 256 * KiB, WS_GRAN = WS_CTL + CTL_BAR_BYTES, WS_CNT = WS_GRAN + 1 * MiB, CTL_ZERO_BYTES = CTL_BAR_BYTES + 1 * MiB + 256 * KiB, WS_SQP = WS_CTL + CTL_ZERO_BYTES;
constexpr size_t WS_META = 1 * MiB;
constexpr size_t MO_HM = 0, MO_HMB = 64 * KiB, MO_BM = 96 * KiB, MO_UM = 128 * KiB, MO_VM = 160 * KiB, MO_YM = 192 * KiB, MO_FM = 224 * KiB, MO_KM = 352 * KiB, MO_VTM = 384 * KiB, MO_RS = 512 * KiB;
constexpr size_t WS_WIN = 2 * MiB, WS_WOUT = 14 * MiB, WS_WQK = 18 * MiB, WS_WV = 22 * MiB, WS_WQ3 = 24 * MiB, WS_WO = 26 * MiB, WS_W1 = 30 * MiB, WS_W2 = 62 * MiB;
constexpr size_t WS_HB = 96 * MiB, WS_R0 = 160 * MiB, WS_K = 224 * MiB, WS_VT = 288 * MiB, WS_R1 = 352 * MiB, WS_R2 = 416 * MiB, WS_MH = 482 * MiB, WS_END = 483 * MiB;
constexpr int CW_BAR = 4096;
static_assert((CW_BAR + 3456) * 4 <= (int)(64 * KiB), "barrier words inside the memset region");

constexpr int RING_BYTES = 131072, MISC_OFF = RING_BYTES + 320, LDS_BYTES = 147456;

typedef float f32x16 __attribute__((ext_vector_type(16)));
typedef unsigned u32x2 __attribute__((ext_vector_type(2)));

__device__ __forceinline__ float wave_sum(float v) {
#pragma unroll
    for (int o = 1; o < 64; o <<= 1) v += __shfl_xor(v, o);
    return v;
}
__device__ __forceinline__ float bflo(unsigned w) { return __uint_as_float(w << 16); }
__device__ __forceinline__ float bfhi(unsigned w) { return __uint_as_float(w & 0xffff0000u); }
__device__ __forceinline__ unsigned cvtpk(float lo, float hi) { return pg8::cvt_pk_bf16(lo, hi); }
__device__ __forceinline__ void unpack8(const v4u w, float (&f)[8]) { f[0] = bflo(w.x); f[1] = bfhi(w.x); f[2] = bflo(w.y); f[3] = bfhi(w.y); f[4] = bflo(w.z); f[5] = bfhi(w.z); f[6] = bflo(w.w); f[7] = bfhi(w.w); }

__device__ __forceinline__ void cvt_item(const float* W, int K, int N, bf16* WT, const float* gain, float scale, int mode, LAS float* scr, int item, int lane) {
    const int nblk = N / 32, kb = item / nblk, nb = item % nblk, k0 = 64 * kb, n0 = 32 * nb;
    f32x4 wv[8];
#pragma unroll
    for (int i = 0; i < 8; ++i) wv[i] = *(const f32x4*)(W + (size_t)(k0 + 8 * i + (lane >> 3)) * N + n0 + 4 * (lane & 7));
    const float* gp = gain ? gain + k0 : W;
    float gq[8];
#pragma unroll
    for (int i = 0; i < 8; ++i) gq[i] = gp[8 * i + (lane >> 3)];
#pragma unroll
    for (int i = 0; i < 8; ++i) { const int kk = 8 * i + (lane >> 3); const float gs = gain ? gq[i] * scale : scale; LAS float* d = scr + kk * 33 + 4 * (lane & 7);
        d[0] = wv[i].x * gs; d[1] = wv[i].y * gs; d[2] = wv[i].z * gs; d[3] = wv[i].w * gs; }
    LDS_WAIT(); asm volatile("" ::: "memory");
    int nd0 = n0;
    if (mode == 1 && n0 >= 1024) { const int o = (n0 - 1024) & 1023; nd0 = 1024 + 256 * (o >> 7) + (n0 >= 2048 ? 128 : 0) + (o & 127); }
    const int c = lane & 7;
#pragma unroll
    for (int j = 0; j < 4; ++j) { const int n = (lane >> 3) + 8 * j; const LAS float* s = scr + (8 * c) * 33 + n;
        v4u o; o.x = pk2(s[0 * 33], s[1 * 33]); o.y = pk2(s[2 * 33], s[3 * 33]); o.z = pk2(s[4 * 33], s[5 * 33]); o.w = pk2(s[6 * 33], s[7 * 33]);
        const int nr = nd0 + n;
        *(GAS v4u*)(WT + (size_t)(nr >> 8) * 256 * K + (size_t)(k0 >> 6) * (256 * 64) + (nr & 255) * 64 + 8 * c) = o; }
    LDS_WAIT(); asm volatile("" ::: "memory");
}
__device__ __forceinline__ void norm_row_to_bf16(const float* xrow, bf16* orow, int lane) {
    const f32x4* xr = (const f32x4*)xrow + lane;
    f32x4 v[4]; float s = 0.f;
#pragma unroll
    for (int j = 0; j < 4; ++j) { v[j] = xr[64 * j]; s += (v[j].x * v[j].x + v[j].y * v[j].y) + (v[j].z * v[j].z + v[j].w * v[j].w); }
    const float r = 1.f / sqrtf(wave_sum(s) * (1.f / D) + EPS);
    u32x2* o8 = (u32x2*)orow + lane;
#pragma unroll
    for (int j = 0; j < 4; ++j) { u32x2 w; w.x = cvtpk(v[j].x * r, v[j].y * r); w.y = cvtpk(v[j].z * r, v[j].w * r); o8[64 * j] = w; }
}
template <int NRW>
__device__ __forceinline__ void raw_rows_to_bf16(const float* x0, bf16* o0, float* rs0, int lane) {
    f32x4 v[NRW][4]; float s[NRW];
#pragma unroll
    for (int r = 0; r < NRW; ++r) { const f32x4* xr = (const f32x4*)(x0 + (size_t)r * D) + 2 * lane;
#pragma unroll
        for (int j = 0; j < 2; ++j) { v[r][2 * j] = xr[128 * j]; v[r][2 * j + 1] = xr[128 * j + 1]; } }
#pragma unroll
    for (int r = 0; r < NRW; ++r) { float a = 0.f;
#pragma unroll
        for (int j = 0; j < 4; ++j) a += (v[r][j].x * v[r][j].x + v[r][j].y * v[r][j].y) + (v[r][j].z * v[r][j].z + v[r][j].w * v[r][j].w);
        s[r] = a; }
#pragma unroll
    for (int o = 1; o < 64; o <<= 1) {
#pragma unroll
        for (int r = 0; r < NRW; ++r) s[r] += __shfl_xor(s[r], o); }
#pragma unroll
    for (int r = 0; r < NRW; ++r) {
        if (lane == 0) rs0[r] = 1.f / sqrtf(s[r] * (1.f / D) + EPS);
#pragma unroll
        for (int j = 0; j < 2; ++j) { v4u w; w.x = cvtpk(v[r][2 * j].x, v[r][2 * j].y); w.y = cvtpk(v[r][2 * j].z, v[r][2 * j].w); w.z = cvtpk(v[r][2 * j + 1].x, v[r][2 * j + 1].y); w.w = cvtpk(v[r][2 * j + 1].z, v[r][2 * j + 1].w);
            *((v4u*)(o0 + (size_t)r * D) + lane + 64 * j) = w; } }
}
template <bool HIN32, bool OUT32>
__device__ __forceinline__ void nr_rows16(const bf16* y0, const void* hin0, void* hout0, float* rs0, const float* gain, int lane) {
    float g[16];
#pragma unroll
    for (int j = 0; j < 2; ++j) { const f32x4 g0 = *((const f32x4*)gain + 2 * lane + 128 * j), g1 = *((const f32x4*)gain + 2 * lane + 128 * j + 1);
        g[8 * j] = g0.x; g[8 * j + 1] = g0.y; g[8 * j + 2] = g0.z; g[8 * j + 3] = g0.w; g[8 * j + 4] = g1.x; g[8 * j + 5] = g1.y; g[8 * j + 6] = g1.z; g[8 * j + 7] = g1.w; }
    struct Raw { v4u y[2][2]; v4u hb[2][2]; f32x4 hf[2][4]; };
    auto load = [&](Raw& R, int r0) {
#pragma unroll
        for (int r = 0; r < 2; ++r)
#pragma unroll
            for (int j = 0; j < 2; ++j) { R.y[r][j] = *((const v4u*)(y0 + (size_t)(r0 + r) * D) + lane + 64 * j);
                if constexpr (HIN32) { const f32x4* hp = (const f32x4*)((const float*)hin0 + (size_t)(r0 + r) * D) + 2 * lane + 128 * j; R.hf[r][2 * j] = hp[0]; R.hf[r][2 * j + 1] = hp[1]; }
                else R.hb[r][j] = *((const v4u*)((const bf16*)hin0 + (size_t)(r0 + r) * D) + lane + 64 * j); }
    };
    auto proc = [&](const Raw& R, int r0) {
        float y[2][16], hv[2][16], ss[2], s2[2];
#pragma unroll
        for (int r = 0; r < 2; ++r) { float a = 0.f;
#pragma unroll
            for (int j = 0; j < 2; ++j) { float t[8]; unpack8(R.y[r][j], t);
#pragma unroll
                for (int e = 0; e < 8; ++e) { y[r][8 * j + e] = t[e]; a += t[e] * t[e]; }
                if constexpr (HIN32) { const f32x4 p = R.hf[r][2 * j], q = R.hf[r][2 * j + 1];
                    hv[r][8 * j] = p.x; hv[r][8 * j + 1] = p.y; hv[r][8 * j + 2] = p.z; hv[r][8 * j + 3] = p.w; hv[r][8 * j + 4] = q.x; hv[r][8 * j + 5] = q.y; hv[r][8 * j + 6] = q.z; hv[r][8 * j + 7] = q.w; }
                else { float u[8]; unpack8(R.hb[r][j], u);
#pragma unroll
                    for (int e = 0; e < 8; ++e) hv[r][8 * j + e] = u[e]; } }
            ss[r] = a; }
#pragma unroll
        for (int o = 1; o < 64; o <<= 1) { ss[0] += __shfl_xor(ss[0], o); ss[1] += __shfl_xor(ss[1], o); }
#pragma unroll
        for (int r = 0; r < 2; ++r) { const float ry = 1.f / sqrtf(ss[r] * (1.f / D) + EPS);
#pragma unroll
            for (int e = 0; e < 16; ++e) hv[r][e] += (y[r][e] * ry) * g[e];
            if constexpr (OUT32) {
#pragma unroll
                for (int j = 0; j < 2; ++j) { f32x4* op = (f32x4*)((float*)hout0 + (size_t)(r0 + r) * D) + 2 * lane + 128 * j;
                    op[0] = (f32x4){hv[r][8 * j], hv[r][8 * j + 1], hv[r][8 * j + 2], hv[r][8 * j + 3]}; op[1] = (f32x4){hv[r][8 * j + 4], hv[r][8 * j + 5], hv[r][8 * j + 6], hv[r][8 * j + 7]}; }
            } else { float a = 0.f;
#pragma unroll
                for (int j = 0; j < 2; ++j) { v4u w; w.x = cvtpk(hv[r][8 * j], hv[r][8 * j + 1]); w.y = cvtpk(hv[r][8 * j + 2], hv[r][8 * j + 3]); w.z = cvtpk(hv[r][8 * j + 4], hv[r][8 * j + 5]); w.w = cvtpk(hv[r][8 * j + 6], hv[r][8 * j + 7]);
                    *((v4u*)((bf16*)hout0 + (size_t)(r0 + r) * D) + lane + 64 * j) = w;
                    float t[8]; unpack8(w, t);
#pragma unroll
                    for (int e = 0; e < 8; ++e) a += t[e] * t[e]; }
                s2[r] = a; } }
        if constexpr (!OUT32) {
#pragma unroll
            for (int o = 1; o < 64; o <<= 1) { s2[0] += __shfl_xor(s2[0], o); s2[1] += __shfl_xor(s2[1], o); }
            if (lane == 0) { rs0[r0] = 1.f / sqrtf(s2[0] * (1.f / D) + EPS); rs0[r0 + 1] = 1.f / sqrtf(s2[1] * (1.f / D) + EPS); }
        }
    };
    Raw A, B;
    load(A, 0);
#pragma unroll
    for (int gq = 0; gq < 8; gq += 2) {
        load(B, 2 * (gq + 1));
        proc(A, 2 * gq);
        if (gq + 2 < 8) load(A, 2 * (gq + 2));
        proc(B, 2 * (gq + 1));
    }
}
__device__ __forceinline__ void nr_row(const bf16* yrow, const float* hin, float* hout, bf16* hbrow, const float* gain, int lane) {
    f32x4 hv[4], yv[4]; float ss = 0.f;
#pragma unroll
    for (int j = 0; j < 4; ++j) { const u32x2 w = *((const u32x2*)yrow + lane + 64 * j); yv[j] = (f32x4){bflo(w.x), bfhi(w.x), bflo(w.y), bfhi(w.y)};
        hv[j] = *((const f32x4*)hin + lane + 64 * j); ss += (yv[j].x * yv[j].x + yv[j].y * yv[j].y) + (yv[j].z * yv[j].z + yv[j].w * yv[j].w); }
    const float ry = 1.f / sqrtf(wave_sum(ss) * (1.f / D) + EPS);
    float s2 = 0.f;
#pragma unroll
    for (int j = 0; j < 4; ++j) { const f32x4 g4 = *((const f32x4*)gain + lane + 64 * j); hv[j] = hv[j] + (yv[j] * ry) * g4; *((f32x4*)hout + lane + 64 * j) = hv[j];
        s2 += (hv[j].x * hv[j].x + hv[j].y * hv[j].y) + (hv[j].z * hv[j].z + hv[j].w * hv[j].w); }
    const float rh = 1.f / sqrtf(wave_sum(s2) * (1.f / D) + EPS);
#pragma unroll
    for (int j = 0; j < 4; ++j) { u32x2 w; w.x = cvtpk(hv[j].x * rh, hv[j].y * rh); w.y = cvtpk(hv[j].z * rh, hv[j].w * rh); *((u32x2*)hbrow + lane + 64 * j) = w; }
}
__device__ __forceinline__ f32x4 meta_tile(const bf16* A, const bf16* Wt, int K, int n0, LAS float* red, int wave, int lane) {
    const int kw = K >> 3, kbeg = wave * kw;
    const bf16* ap = A + (size_t)(lane & 15) * K + kbeg + 8 * (lane >> 4);
    const int nn = n0 + (lane & 15); const bf16* bp = Wt + (size_t)(nn >> 8) * 256 * K + (nn & 255) * 64;
    const int kb0 = kbeg + 8 * (lane >> 4);
    f32x4 acc = (f32x4){0.f, 0.f, 0.f, 0.f};
#pragma unroll 8
    for (int k = 0; k < kw; k += 32) { const bf16x8 a = *(const bf16x8*)(ap + k); const int kk = kb0 + k; const bf16x8 b = *(const bf16x8*)(bp + (size_t)(kk >> 6) * (256 * 64) + (kk & 63)); acc = __builtin_amdgcn_mfma_f32_16x16x32_bf16(a, b, acc, 0, 0, 0); }
    *((LAS f32x4*)red + wave * 64 + lane) = acc;
    __syncthreads();
    if (wave == 0) {
#pragma unroll
        for (int w = 1; w < 8; ++w) acc = acc + *((LAS f32x4*)red + w * 64 + lane);
    }
    __syncthreads();
    return acc;
}

template <bool MASKED>
__device__ __forceinline__ void attn_step(const bf16x8 (&ck)[4], const bf16x8 (&cv)[4], const bf16x8 (&qf)[4], f32x16& o0, f32x16& o1, float& Rp, float& Rl, int q, int h, bool metab) {
    f32x16 st;
#pragma unroll
    for (int r = 0; r < 16; ++r) st[r] = 0.f;
    __builtin_amdgcn_s_setprio(1);
#pragma unroll
    for (int s = 0; s < 4; ++s) st = __builtin_amdgcn_mfma_f32_32x32x16_bf16(ck[s], qf[s], st, 0, 0, 0);
    __builtin_amdgcn_s_setprio(0);
    typedef float f32x2 __attribute__((ext_vector_type(2)));
    f32x2 BE[8], OM[8];
#pragma unroll
    for (int j = 0; j < 8; ++j) {
        const f32x2 t = {__builtin_amdgcn_exp2f(-st[j]), __builtin_amdgcn_exp2f(-st[8 + j])};
        const f32x2 d = t + 1.f;
        f32x2 b = {__builtin_amdgcn_rcpf(d.x), __builtin_amdgcn_rcpf(d.y)};
        f32x2 w = 1.f - b;
        if (MASKED) { const int kA = j + 8 * h, kB = j + 8 * h + 16; const bool vA = metab ? (kA < NMETA) : (kA < q), vB = metab ? (kB < NMETA) : (kB < q);
            b.x = vA ? b.x : 0.f; w.x = vA ? w.x : 1.f; b.y = vB ? b.y : 0.f; w.y = vB ? w.y : 1.f; }
        BE[j] = b; OM[j] = w;
    }
    f32x2 pAB[8];
    pAB[7] = (f32x2){1.f, 1.f};
#pragma unroll
    for (int j = 6; j >= 0; --j) pAB[j] = OM[j + 1] * pAB[j + 1];
    const f32x2 TAB = OM[0] * pAB[0];
    const float TA = TAB.x, TB = TAB.y;
    float TAp, TBp;
    { auto ra = __builtin_amdgcn_permlane32_swap(__float_as_uint(TA), __float_as_uint(TA), false, false); TAp = __uint_as_float(h == 0 ? ra[1] : ra[0]);
      auto rb = __builtin_amdgcn_permlane32_swap(__float_as_uint(TB), __float_as_uint(TB), false, false); TBp = __uint_as_float(h == 0 ? rb[1] : rb[0]); }
    const float baseA = ((h == 0) ? (TAp * TB) * TBp : TBp * TB) * Rp;
    const float baseB = ((h == 0) ? TBp : 1.f) * Rp;
    const f32x2 base2 = {baseA, baseB};
    float a[16];
#pragma unroll
    for (int j = 0; j < 8; ++j) { const f32x2 aj = (BE[j] * base2) * pAB[j]; a[j] = aj.x; a[8 + j] = aj.y; }
    const float Tblk = (TA * TAp) * (TB * TBp);
    Rp *= Tblk; Rl -= __builtin_amdgcn_logf(Tblk);
    v4u p0w, p1w;
    p0w.x = cvtpk(a[0], a[1]); p0w.y = cvtpk(a[2], a[3]); p0w.z = cvtpk(a[4], a[5]); p0w.w = cvtpk(a[6], a[7]);
    p1w.x = cvtpk(a[8], a[9]); p1w.y = cvtpk(a[10], a[11]); p1w.z = cvtpk(a[12], a[13]); p1w.w = cvtpk(a[14], a[15]);
    const bf16x8 p0 = __builtin_bit_cast(bf16x8, p0w), p1 = __builtin_bit_cast(bf16x8, p1w);
    __builtin_amdgcn_s_setprio(1);
    o0 = __builtin_amdgcn_mfma_f32_32x32x16_bf16(cv[0], p0, o0, 0, 0, 0); o1 = __builtin_amdgcn_mfma_f32_32x32x16_bf16(cv[2], p0, o1, 0, 0, 0);
    o0 = __builtin_amdgcn_mfma_f32_32x32x16_bf16(cv[1], p1, o0, 0, 0, 0); o1 = __builtin_amdgcn_mfma_f32_32x32x16_bf16(cv[3], p1, o1, 0, 0, 0);
    __builtin_amdgcn_s_setprio(0);
}
constexpr int ATT_PF = 6;
__device__ __forceinline__ void glds16(const void* gsrc, unsigned lds_dst) { unsigned keep;
    asm volatile("s_mov_b32 %0, m0\n\ts_mov_b32 m0, %2\n\ts_nop 0\n\tglobal_load_lds_dwordx4 %1, off\n\ts_mov_b32 m0, %0" : "=&s"(keep) : "v"(gsrc), "s"(lds_dst) : "memory"); }
__device__ __forceinline__ void attn_phase(LAS unsigned char* lds, const bf16* Q, const bf16* Kb, const bf16* Vt, const bf16* Km, const bf16* Vtm, bf16* O, int vcu, int G, int wave, int lane) {
    constexpr int NU = NB * NH * (S / 256);
    int id = vcu;
    if (id >= NU) return;
    const int q = lane & 31, h = lane >> 5;
    const int pi = (q & 0x13) | (((q >> 2) & 1) << 3) | (((q >> 3) & 1) << 2);
    const unsigned lds0 = (unsigned)(size_t)lds;
    const int ddst = (wave < 4) ? wave * 1024 : 4096 + (wave - 4) * 1024;
    const int kx = (pi >> 1) & 7, vx = (q >> 2) & 3;
    int kro[4], vro[4];
#pragma unroll
    for (int s = 0; s < 4; ++s) kro[s] = pi * 128 + (((2 * s + h) ^ kx) << 4);
#pragma unroll
    for (int s = 0; s < 2; ++s) { vro[s] = 4096 + q * 64 + (((2 * s + h) ^ vx) << 4); vro[2 + s] = vro[s] + 32 * 64; }
    volatile LAS unsigned* flags = (volatile LAS unsigned*)(lds + RING_BYTES);
    const bf16* dsrc; size_t dstep; int B0, qblk, hh; size_t rowbase;
    bf16x8 qn[4];
#define DMA_BLOCK(X) do { const int X_ = (X); const int Xc_ = X_ < 0 ? 0 : X_; \
        glds16(dsrc + (size_t)Xc_ * dstep, (unsigned)__builtin_amdgcn_readfirstlane((int)(lds0 + (((X_ & 15) << 13) + ddst)))); } while (0)
#define UNIT_SETUP(ID) do { const int bh_ = (ID) >> 5, ub_ = (ID) & 31; hh = bh_ & 15; rowbase = (size_t)(bh_ >> 4) * S; B0 = ub_ * 8; qblk = B0 + wave; \
        { const bf16* qp_ = Q + (rowbase + (size_t)qblk * 32 + q) * D + hh * HD + 8 * h; _Pragma("unroll") for (int s = 0; s < 4; ++s) qn[s] = *(const bf16x8*)(qp_ + 16 * s); } \
        if (wave < 4) { const int r_ = 8 * wave + (lane >> 3), c_ = (lane & 7) ^ ((r_ >> 1) & 7); dsrc = Kb + (rowbase + r_) * D + hh * HD + c_ * 8; dstep = (size_t)32 * D; } \
        else { const int d_ = 16 * (wave - 4) + (lane >> 2), c_ = (lane & 3) ^ ((d_ >> 2) & 3); dsrc = Vt + (size_t)(hh * HD + d_) * M + rowbase + c_ * 8; dstep = 32; } \
        _Pragma("unroll") for (int X = 7; X >= 1 - ATT_PF; --X) DMA_BLOCK(B0 + X); } while (0)
    UNIT_SETUP(id);
    for (;;) {
        bf16x8 qf[4];
#pragma unroll
        for (int s = 0; s < 4; ++s) qf[s] = qn[s];
        asm volatile("" : "+v"(qf[0]), "+v"(qf[1]), "+v"(qf[2]), "+v"(qf[3]));
        f32x16 o0, o1;
#pragma unroll
        for (int r = 0; r < 16; ++r) { o0[r] = 0.f; o1[r] = 0.f; }
        float Rp = 1.f, Rl = 0.f; bool done = false;
        for (int i = 0;; ++i) {
            asm volatile("s_waitcnt vmcnt(5) lgkmcnt(0)" ::: "memory");
            __builtin_amdgcn_s_barrier();
            asm volatile("" ::: "memory");
            if (i > 0) { const LAS unsigned* fp = (const LAS unsigned*)(lds + RING_BYTES) + ((i - 1) & 1) * 8;
                const v4u fa = *(const LAS v4u*)fp, fb = *(const LAS v4u*)(fp + 4);
                const unsigned all_done = (fa.x & fa.y & fa.z & fa.w) & (fb.x & fb.y & fb.z & fb.w);
                if (__builtin_amdgcn_readfirstlane(all_done)) break; }
            DMA_BLOCK(B0 - i - ATT_PF);
            if (!done) {
                const int jb = qblk - i;
                bf16x8 ck[4], cv[4];
                if (jb >= 0) {
                    const LAS unsigned char* sb = lds + ((jb & 15) << 13);
#pragma unroll
                    for (int s = 0; s < 4; ++s) { ck[s] = *(const LAS bf16x8*)(sb + kro[s]); cv[s] = *(const LAS bf16x8*)(sb + vro[s]); }
                    if (i == 0) attn_step<true>(ck, cv, qf, o0, o1, Rp, Rl, q, h, false); else attn_step<false>(ck, cv, qf, o0, o1, Rp, Rl, q, h, false);
                } else {
                    const bf16* kmp = Km + (size_t)(pi & 15) * D + hh * HD + 8 * h; const bf16* vmp = Vtm + (size_t)(hh * HD + q) * NMETA + 8 * h;
#pragma unroll
                    for (int s = 0; s < 4; ++s) ck[s] = *(const bf16x8*)(kmp + 16 * s);
                    cv[0] = *(const bf16x8*)(vmp); cv[1] = cv[0]; cv[2] = *(const bf16x8*)(vmp + 32 * NMETA); cv[3] = cv[2];
                    attn_step<true>(ck, cv, qf, o0, o1, Rp, Rl, q, h, true);
                    done = true;
                }
                if (__all(Rl > SB_THRESH)) done = true;
            }
            if (lane == 0) flags[(i & 1) * 8 + wave] = done ? 0xffffffffu : 0u;
        }
        bf16* op = O + (rowbase + (size_t)qblk * 32 + q) * D + hh * HD + 4 * h;
        const int nid = id + G; const bool more = nid < NU;
        if (more) UNIT_SETUP(nid);
#pragma unroll
        for (int g = 0; g < 4; ++g) { u32x2 w0, w1; w0.x = cvtpk(o0[4 * g], o0[4 * g + 1]); w0.y = cvtpk(o0[4 * g + 2], o0[4 * g + 3]); w1.x = cvtpk(o1[4 * g], o1[4 * g + 1]); w1.y = cvtpk(o1[4 * g + 2], o1[4 * g + 3]);
            *(u32x2*)(op + 8 * g) = w0; *(u32x2*)(op + 32 + 8 * g) = w1; }
        if (!more) break;
        id = nid;
    }
#undef UNIT_SETUP
#undef DMA_BLOCK
    asm volatile("s_waitcnt vmcnt(0) lgkmcnt(0)" ::: "memory");
    __builtin_amdgcn_s_barrier();
    asm volatile("" ::: "memory");
}

struct Args { const float* in[13]; float* out; unsigned char* ws; };
__global__ void __launch_bounds__(NWAVES * 64, 2) yoco_fwd(Args args) {
    extern __shared__ __attribute__((aligned(16))) unsigned char lds_raw[];
    LAS unsigned char* lds = (LAS unsigned char*)lds_raw;
    volatile LAS unsigned* MISC = (volatile LAS unsigned*)(lds + MISC_OFF);
    const int G = gridDim.x, bx = blockIdx.x;
    const int vcu = (G % 8 == 0) ? (bx % 8) * (G / 8) + bx / 8 : bx;
    const int NGW = G * NWAVES;
    const float* x = args.in[0]; const float* meta_tokens = args.in[1]; const float* ng = args.in[2]; const float* conv_in = args.in[3]; const float* conv_w = args.in[4];
    const float* conv_out = args.in[5]; const float* kv_norm = args.in[6]; const float* w_k = args.in[7]; const float* w_v = args.in[8]; const float* w_q = args.in[9];
    const float* w_o = args.in[10]; const float* mlp_w1 = args.in[11]; const float* mlp_w2 = args.in[12];
    float* out = args.out;
    LAS float* red = (LAS float*)lds;
#define PHASE_BEGIN \
    int tid = threadIdx.x; asm volatile("" : "+v"(tid)); \
    const int lane = tid & 63, wave = __builtin_amdgcn_readfirstlane(tid >> 6); \
    GAS unsigned char* wsg_ = (GAS unsigned char*)args.ws; asm volatile("" : "+s"(wsg_)); unsigned char* ws = (unsigned char*)wsg_; \
    const int gw = vcu * NWAVES + wave; (void)gw; (void)lane;
#define Win_t ((bf16*)(ws + WS_WIN))
#define Wout_t ((bf16*)(ws + WS_WOUT))
#define Wqk_t ((bf16*)(ws + WS_WQK))
#define Wv_t ((bf16*)(ws + WS_WV))
#define Wq3_t ((bf16*)(ws + WS_WQ3))
#define Wo_t ((bf16*)(ws + WS_WO))
#define W1_t ((bf16*)(ws + WS_W1))
#define W2_t ((bf16*)(ws + WS_W2))
#define HB ((bf16*)(ws + WS_HB))
#define KB ((bf16*)(ws + WS_K))
#define VT ((bf16*)(ws + WS_VT))
#define R0 ((bf16*)(ws + WS_R0))
#define R1 ((bf16*)(ws + WS_R1))
#define R2 ((bf16*)(ws + WS_R2))
#define hmS(k_) ((float*)(ws + WS_MH) + (size_t)(k_) * NMETA * D)
#define hmbS(k_) ((bf16*)(ws + WS_MH + 256 * KiB) + (size_t)(k_) * NMETA * D)
#define META_NR(k_, gain_) do { const int k__ = (k_); const float* hin_ = (k__ == 0) ? meta_tokens : hmS(k__ - 1); \
        for (int r_ = wave; r_ < NMETA; r_ += NWAVES) nr_row(ym + (size_t)r_ * D, hin_ + (size_t)r_ * D, hmS(k__) + (size_t)r_ * D, hmbS(k__) + (size_t)r_ * D, (gain_), lane); \
        asm volatile("s_waitcnt vmcnt(0)" ::: "memory"); __syncthreads(); } while (0)
#define hmb ((bf16*)(ws + WS_META + MO_HMB))
#define bm ((bf16*)(ws + WS_META + MO_BM))
#define um ((bf16*)(ws + WS_META + MO_UM))
#define vm ((bf16*)(ws + WS_META + MO_VM))
#define ym ((bf16*)(ws + WS_META + MO_YM))
#define fm ((bf16*)(ws + WS_META + MO_FM))
#define km ((bf16*)(ws + WS_META + MO_KM))
#define vtm ((bf16*)(ws + WS_META + MO_VTM))
#define RS ((float*)(ws + WS_META + MO_RS))

    if (threadIdx.x < 32) MISC[threadIdx.x] = 0u;
    __syncthreads();
    XcdBarrier bar = xcd_barrier_post((unsigned*)(args.ws + WS_CTL) + CW_BAR, MISC + 8);
#define GRID_BAR() do { XcdBarrier b_ = bar; b_.x = xb_xcc_id(); GAS unsigned* bg_ = (GAS unsigned*)b_.bar; asm volatile("" : "+s"(bg_)); b_.bar = (unsigned*)bg_; xcd_barrier(b_); } while (0)

    {
        PHASE_BEGIN
        LAS float* scr = (LAS float*)(lds + wave * 16384);
        constexpr int NITEMS = 23552;
        for (int it = gw; it < NITEMS; it += NGW) {
            int r = it;
            if (r < 3072) { const int l = r / 1536; cvt_item(conv_in + (size_t)l * D * 3 * D, D, 3 * D, Win_t + (size_t)l * 3 * D * D, ng + (size_t)(l * 4 + 0) * D, 1.f, 1, scr, r % 1536, lane); continue; } r -= 3072;
            if (r < 1024) { const int l = r / 512; cvt_item(conv_out + (size_t)l * D * D, D, D, Wout_t + (size_t)l * D * D, nullptr, 1.f, 0, scr, r % 512, lane); continue; } r -= 1024;
            if (r < 512) { cvt_item(w_q, D, D, Wqk_t, ng + (size_t)(2 * 4 + 0) * D, QSCALE, 0, scr, r, lane); continue; } r -= 512;
            if (r < 512) { cvt_item(w_k, D, D, Wqk_t + (size_t)D * D, kv_norm, 1.f, 0, scr, r, lane); continue; } r -= 512;
            if (r < 512) { cvt_item(w_v, D, D, Wv_t, kv_norm, 1.f, 0, scr, r, lane); continue; } r -= 512;
            if (r < 512) { cvt_item(w_q + (size_t)D * D, D, D, Wq3_t, ng + (size_t)(3 * 4 + 0) * D, QSCALE, 0, scr, r, lane); continue; } r -= 512;
            if (r < 1024) { const int l = r / 512; cvt_item(w_o + (size_t)l * D * D, D, D, Wo_t + (size_t)l * D * D, nullptr, 1.f, 0, scr, r % 512, lane); continue; } r -= 1024;
            if (r < 8192) { const int l = r / 2048; cvt_item(mlp_w1 + (size_t)l * D * FF, D, FF, W1_t + (size_t)l * FF * D, ng + (size_t)(l * 4 + 2) * D, 1.f, 0, scr, r % 2048, lane); continue; } r -= 8192;
            { const int l = r / 2048; cvt_item(mlp_w2 + (size_t)l * FF * D, FF, D, W2_t + (size_t)l * D * FF, nullptr, 1.f, 0, scr, r % 2048, lane); }
        }
        {
            const int rows_it = NGW * 4; const int nit = (gw * 4 < M) ? (M - gw * 4 + rows_it - 1) / rows_it : 0; const int nr = 4 * nit;
            const unsigned ringw = (unsigned)(size_t)lds + (unsigned)wave * 16384u;
            LAS unsigned char* ringp = lds + wave * 16384;
#define XROW(r_) ((size_t)(gw * 4) + (size_t)((r_) >> 2) * rows_it + ((r_) & 3))
#define XISSUE(r_) do { const float* src_ = x + XROW(r_) * D + 4 * lane; const unsigned dst_ = ringw + (unsigned)((r_) & 3) * 4096u; \
                _Pragma("unroll") for (int j_ = 0; j_ < 4; ++j_) glds16(src_ + 256 * j_, dst_ + j_ * 1024); } while (0)
            for (int r = 0; r < 4 && r < nr; ++r) XISSUE(r);
#pragma clang loop unroll(disable)
            for (int r = 0; r < nr; ++r) {
                if (r + 3 < nr) asm volatile("s_waitcnt vmcnt(12)" ::: "memory"); else asm volatile("s_waitcnt vmcnt(0)" ::: "memory");
                f32x4 v[4];
#pragma unroll
                for (int j = 0; j < 4; ++j) v[j] = *(const LAS f32x4*)(ringp + (r & 3) * 4096 + j * 1024 + lane * 16);
                asm volatile("s_waitcnt lgkmcnt(0)" ::: "memory");
#pragma unroll
                for (int j = 0; j < 4; ++j) asm volatile("" : "+v"(v[j]));
                if (r + 4 < nr) XISSUE(r + 4);
                float s = 0.f;
#pragma unroll
                for (int j = 0; j < 4; ++j) s += (v[j].x * v[j].x + v[j].y * v[j].y) + (v[j].z * v[j].z + v[j].w * v[j].w);
                s = wave_sum(s);
                const size_t row = XROW(r);
                if (lane == 0) RS[row] = 1.f / sqrtf(s * (1.f / D) + EPS);
                u32x2* o8 = (u32x2*)(HB + row * D) + lane;
#pragma unroll
                for (int j = 0; j < 4; ++j) { u32x2 w; w.x = cvtpk(v[j].x, v[j].y); w.y = cvtpk(v[j].z, v[j].w); o8[64 * j] = w; }
            }
#undef XROW
#undef XISSUE
        }
        for (int r = gw; r < NMETA; r += NGW) norm_row_to_bf16(meta_tokens + (size_t)r * D, hmb + (size_t)r * D, lane);
        {
            constexpr size_t NZ = (1 * MiB + 256 * KiB) / 16;
            for (size_t i = (size_t)vcu * (NWAVES * 64) + tid; i < NZ; i += (size_t)G * (NWAVES * 64)) ((v4u*)(ws + WS_GRAN))[i] = (v4u){0u, 0u, 0u, 0u};
        }
    }
    GRID_BAR();

#pragma clang loop unroll(disable)
    for (int layer = 0; layer < DEPTH; ++layer) {
        const float* gl = ng + (size_t)layer * 4 * D;
        const bool has_meta = layer < 2;
        if (layer < 2) {
            {
                PHASE_BEGIN
                const bf16* W = Win_t + (size_t)layer * 3 * D * D;
                if (layer > 0 && bx < 128) META_NR(2 * (layer - 1) + 1, gl - D);
                const bf16* hmbl = (layer == 0) ? hmb : hmbS(2 * (layer - 1) + 1);
                for (int t = bx; t < 128; t += G) {
                    if (t < 64) { const f32x4 acc = meta_tile(hmbl, W, D, 16 * t, red, wave, lane);
                        if (wave == 0) {
#pragma unroll
                            for (int i = 0; i < 4; ++i) bm[(4 * (lane >> 4) + i) * D + 16 * t + (lane & 15)] = (bf16)f2bf(acc[i]); } }
                    else { const int tt = t - 64, n0c = 1024 + 256 * (tt >> 3) + 16 * (tt & 7);
                        const f32x4 ac = meta_tile(hmbl, W, D, n0c, red, wave, lane); const f32x4 ax = meta_tile(hmbl, W, D, n0c + 128, red, wave, lane);
                        if (wave == 0) {
#pragma unroll
                            for (int i = 0; i < 4; ++i) um[(4 * (lane >> 4) + i) * D + 128 * (tt >> 3) + 16 * (tt & 7) + (lane & 15)] = (bf16)f2bf(ac[i] * ax[i]); } }
                }
                __syncthreads();
                pg8::Gemm g{HB, W, M, 3 * D, D, 0, 1}; pg8::StaticOrder So; So.init(M, 3 * D, G, bx);
                pg8::EpiConvIn E{R0, R1, RS};
                pg8::gemm_phase<pg8::EpiConvIn, pg8::StaticOrder, true, true>(lds, g, So, E);
            }
            GRID_BAR();
            {
                PHASE_BEGIN
                const int chunk = tid & 127, rg = tid >> 7, col0 = chunk * 8;
                const float* cw = conv_w + (size_t)layer * 3 * D + col0;
                float w0[8], w1[8], w2[8];
#pragma unroll
                for (int e = 0; e < 8; ++e) { w0[e] = cw[e]; w1[e] = cw[D + e]; w2[e] = cw[2 * D + e]; }
                const unsigned ring0 = (unsigned)(size_t)lds, wpiece = (unsigned)__builtin_amdgcn_readfirstlane((int)((tid >> 6) * 1024));
                for (int cb = vcu; cb < M / 128; cb += G) {
                    const int r0 = cb * 128 + rg * 32;
                    v4u up2, up1;
                    if ((r0 & (S - 1)) == 0) { up2 = *(const v4u*)(um + 14 * D + col0); up1 = *(const v4u*)(um + 15 * D + col0); }
                    else { up2 = *(const v4u*)(R1 + (size_t)(r0 - 2) * D + col0); up1 = *(const v4u*)(R1 + (size_t)(r0 - 1) * D + col0); }
                    float p2[8], p1[8]; unpack8(up2, p2); unpack8(up1, p1);
#pragma unroll
                    for (int e = 0; e < 8; ++e) { asm volatile("" : "+v"(p2[e])); asm volatile("" : "+v"(p1[e])); }
                    const bf16* usrc = R1 + (size_t)r0 * D + col0; const bf16* bsrc = R0 + (size_t)r0 * D + col0; bf16* vdst = R2 + (size_t)r0 * D + col0;
#pragma unroll
                    for (int k = 0; k < 8; ++k) { glds16(usrc + (size_t)k * D, ring0 + k * 16384 + wpiece); glds16(bsrc + (size_t)k * D, ring0 + k * 16384 + 8192 + wpiece); }
#pragma unroll
                    for (int k = 0; k < 32; ++k) {
                        if (k <= 24) asm volatile("s_waitcnt vmcnt(14)" ::: "memory");
                        else if (k == 25) asm volatile("s_waitcnt vmcnt(12)" ::: "memory");
                        else if (k == 26) asm volatile("s_waitcnt vmcnt(10)" ::: "memory");
                        else if (k == 27) asm volatile("s_waitcnt vmcnt(8)" ::: "memory");
                        else if (k == 28) asm volatile("s_waitcnt vmcnt(6)" ::: "memory");
                        else if (k == 29) asm volatile("s_waitcnt vmcnt(4)" ::: "memory");
                        else if (k == 30) asm volatile("s_waitcnt vmcnt(2)" ::: "memory");
                        else asm volatile("s_waitcnt vmcnt(0)" ::: "memory");
                        const v4u uw = *(const LAS v4u*)(lds + (k & 7) * 16384 + tid * 16), bw = *(const LAS v4u*)(lds + (k & 7) * 16384 + 8192 + tid * 16);
                        float u[8], bb[8], v[8]; unpack8(uw, u); unpack8(bw, bb);
                        asm volatile("s_waitcnt lgkmcnt(0)" ::: "memory");
                        if (k + 8 < 32) { glds16(usrc + (size_t)(k + 8) * D, ring0 + (k & 7) * 16384 + wpiece); glds16(bsrc + (size_t)(k + 8) * D, ring0 + (k & 7) * 16384 + 8192 + wpiece); }
#pragma unroll
                        for (int e = 0; e < 8; ++e) { v[e] = bb[e] * (w0[e] * p2[e] + w1[e] * p1[e] + w2[e] * u[e]); p2[e] = p1[e]; p1[e] = u[e]; }
                        v4u o; o.x = cvtpk(v[0], v[1]); o.y = cvtpk(v[2], v[3]); o.z = cvtpk(v[4], v[5]); o.w = cvtpk(v[6], v[7]);
                        *(v4u*)(vdst + (size_t)k * D) = o;
                    }
                }
                const int gt = vcu * (NWAVES * 64) + tid;
                if (gt < NMETA * 128) {
                    const int t = gt >> 7, c0 = (gt & 127) * 8; const float* cwm = conv_w + (size_t)layer * 3 * D + c0;
                    float u0[8], u1[8], u2[8], bb[8];
                    unpack8(*(const v4u*)(um + t * D + c0), u2); unpack8(*(const v4u*)(bm + t * D + c0), bb);
                    unpack8(*(const v4u*)(um + (t >= 1 ? t - 1 : 0) * D + c0), u1); unpack8(*(const v4u*)(um + (t >= 2 ? t - 2 : 0) * D + c0), u0);
                    const float f1 = t >= 1 ? 1.f : 0.f, f0 = t >= 2 ? 1.f : 0.f;
                    float v[8];
#pragma unroll
                    for (int e = 0; e < 8; ++e) v[e] = bb[e] * (cwm[e] * (u0[e] * f0) + cwm[D + e] * (u1[e] * f1) + cwm[2 * D + e] * u2[e]);
                    v4u o; o.x = cvtpk(v[0], v[1]); o.y = cvtpk(v[2], v[3]); o.z = cvtpk(v[4], v[5]); o.w = cvtpk(v[6], v[7]);
                    *(v4u*)(vm + t * D + c0) = o;
                }
                { LAS float* gl_lds = (LAS float*)(lds + RING_BYTES + 10240); for (int i = tid; i < D; i += NWAVES * 64) gl_lds[i] = gl[D + i]; }
            }
            GRID_BAR();
        } else {
            if (layer == 2) {
                PHASE_BEGIN
                if (bx < 128) META_NR(3, gl - D);
                for (int t = bx; t < 128; t += G) {
                    if (t < 64) { const f32x4 acc = meta_tile(hmbS(3), Wqk_t + (size_t)D * D, D, 16 * t, red, wave, lane);
                        if (wave == 0) {
#pragma unroll
                            for (int i = 0; i < 4; ++i) km[(4 * (lane >> 4) + i) * D + 16 * t + (lane & 15)] = (bf16)f2bf(acc[i]); } }
                    else { const int tt = t - 64; const f32x4 acc = meta_tile(hmbS(3), Wv_t, D, 16 * tt, red, wave, lane);
                        if (wave == 0) {
#pragma unroll
                            for (int i = 0; i < 4; ++i) vtm[(16 * tt + (lane & 15)) * NMETA + 4 * (lane >> 4) + i] = (bf16)f2bf(acc[i]); } }
                }
                __syncthreads();
                { pg8::Gemm g{HB, Wqk_t, M, 2 * D, D, 0, 1}; pg8::StaticOrder So; So.init(M, 2 * D, G, bx);
                  pg8::EpiPlain E{R1, D, D, ((long)WS_K - (long)WS_R1) / 2, RS, nullptr};
                  pg8::gemm_phase<pg8::EpiPlain, pg8::StaticOrder, true, true>(lds, g, So, E); }
                __syncthreads();
                { pg8::Gemm g{Wv_t, HB, D, M, D, 1, 0}; pg8::StaticOrder So; So.init(D, M, G, bx);
                  pg8::EpiPlain E{VT, M, 0, 0, nullptr, RS};
                  pg8::gemm_phase<pg8::EpiPlain, pg8::StaticOrder, true, true>(lds, g, So, E); }
            } else {
                PHASE_BEGIN
                pg8::Gemm g{HB, Wq3_t, M, D, D, 0, 1}; pg8::StaticOrder So; So.init(M, D, G, bx);
                pg8::EpiPlain E{R1, D, 0, 0, RS, nullptr};
                pg8::gemm_phase<pg8::EpiPlain, pg8::StaticOrder, true, true>(lds, g, So, E);
            }
            GRID_BAR();
            { PHASE_BEGIN
            attn_phase(lds, R1, KB, VT, km, vtm, R1, vcu, G, wave, lane);
            { LAS float* gl_lds = (LAS float*)(lds + RING_BYTES + 10240); for (int i = tid; i < D; i += NWAVES * 64) gl_lds[i] = gl[D + i]; }
            }
            GRID_BAR();
        }
        {
            PHASE_BEGIN
            const bf16* Wm = (layer < 2) ? (Wout_t + (size_t)layer * D * D) : (Wo_t + (size_t)(layer - 2) * D * D);
            const bf16* Am = (layer < 2) ? R2 : R1;
            if (has_meta) {
                for (int t = bx; t < 64; t += G) { const f32x4 acc = meta_tile(vm, Wm, D, 16 * t, red, wave, lane);
                    if (wave == 0) {
#pragma unroll
                        for (int i = 0; i < 4; ++i) ym[(4 * (lane >> 4) + i) * D + 16 * t + (lane & 15)] = (bf16)f2bf(acc[i]); } }
                __syncthreads();
            }
            pg8::Gemm g{Am, Wm, M, D, D, 0, 1}; pg8::StaticOrder So; So.init(M, D, G, bx);
            pg8::EpiNormRes<false> E{HB, HB, nullptr, gl + D, RS, (float*)(ws + WS_SQP), (unsigned*)(ws + WS_CNT) + (size_t)(2 * layer) * 128 * 4 * 16, (unsigned long long*)(ws + WS_GRAN), (unsigned)(2 * layer + 1), nullptr,
                                     (LAS float*)(lds + RING_BYTES + 2048), (LAS float*)(lds + RING_BYTES + 6144), (LAS float*)(lds + RING_BYTES + 1024), (const LAS float*)(lds + RING_BYTES + 10240)};
            pg8::gemm_phase<pg8::EpiNormRes<false>, pg8::StaticOrder, true, true>(lds, g, So, E);
        }
        GRID_BAR();
        const int nhalf = (layer == 2) ? 2 : 1;
#pragma clang loop unroll(disable)
        for (int half = 0; half < nhalf; ++half) {
            const int Mh = M / nhalf; const size_t roff = (size_t)half * Mh;
            {
                PHASE_BEGIN
                const bf16* W1l = W1_t + (size_t)layer * FF * D; bf16* Fb = (layer != 2) ? KB : R1;
                if (has_meta && half == 0) {
                    META_NR(2 * layer, gl + D);
                    for (int t = bx; t < 256; t += G) { const f32x4 acc = meta_tile(hmbS(2 * layer), W1l, D, 16 * t, red, wave, lane);
                        if (wave == 0) {
#pragma unroll
                            for (int i = 0; i < 4; ++i) { const float a = fmaxf(acc[i], 0.f); fm[(4 * (lane >> 4) + i) * FF + 16 * t + (lane & 15)] = (bf16)f2bf(a * a); } } }
                    __syncthreads();
                }
                pg8::Gemm g{HB + roff * D, W1l, Mh, FF, D, 0, 1}; pg8::StaticOrder So; So.init(Mh, FF, G, bx);
                pg8::EpiRelu2Raw E{Fb, FF};
                pg8::gemm_phase<pg8::EpiRelu2Raw, pg8::StaticOrder, true, true>(lds, g, So, E);
                { LAS float* gl_lds = (LAS float*)(lds + RING_BYTES + 10240); for (int i = tid; i < D; i += NWAVES * 64) gl_lds[i] = gl[3 * D + i]; }
            }
            GRID_BAR();
            {
                PHASE_BEGIN
                const bf16* W2l = W2_t + (size_t)layer * D * FF; const bf16* Fb = (layer != 2) ? KB : R1;
                if (has_meta && half == 0) {
                    for (int t = bx; t < 64; t += G) { const f32x4 acc = meta_tile(fm, W2l, FF, 16 * t, red, wave, lane);
                        if (wave == 0) {
#pragma unroll
                            for (int i = 0; i < 4; ++i) ym[(4 * (lane >> 4) + i) * D + 16 * t + (lane & 15)] = (bf16)f2bf(acc[i]); } }
                    __syncthreads();
                }
                pg8::Gemm g{Fb, W2l, Mh, D, FF, 1, 1}; pg8::StaticOrder So; So.init(Mh, D, G, bx);
                unsigned long long* granp = (unsigned long long*)(ws + WS_GRAN) + roff; const unsigned tagp = (unsigned)(2 * layer + 2);
                float* sqp = (float*)(ws + WS_SQP) + roff; unsigned* cntp = (unsigned*)(ws + WS_CNT) + ((size_t)(2 * layer + 1) * 128 + roff / 256) * 4 * 16;
                LAS float* xa = (LAS float*)(lds + RING_BYTES + 2048); LAS float* xb = (LAS float*)(lds + RING_BYTES + 6144); LAS float* sarr = (LAS float*)(lds + RING_BYTES + 1024);
                if (layer == DEPTH - 1) {
                    pg8::EpiNormRes<true> E{HB + roff * D, nullptr, out + roff * D, gl + 3 * D, nullptr, sqp, cntp, granp, tagp, RS + roff, xa, xb, sarr, (const LAS float*)(lds + RING_BYTES + 10240)};
                    pg8::gemm_phase<pg8::EpiNormRes<true>, pg8::StaticOrder, true, true>(lds, g, So, E);
                } else {
                    pg8::EpiNormRes<false> E{HB + roff * D, HB + roff * D, nullptr, gl + 3 * D, RS + roff, sqp, cntp, granp, tagp, RS + roff, xa, xb, sarr, (const LAS float*)(lds + RING_BYTES + 10240)};
                    pg8::gemm_phase<pg8::EpiNormRes<false>, pg8::StaticOrder, true, true>(lds, g, So, E);
                }
            }
            if (!(layer == DEPTH - 1 && half == nhalf - 1)) GRID_BAR();
        }
    }
#undef GRID_BAR
#undef PHASE_BEGIN
#undef Win_t
#undef Wout_t
#undef Wqk_t
#undef Wv_t
#undef Wq3_t
#undef Wo_t
#undef W1_t
#undef W2_t
#undef HB
#undef KB
#undef VT
#undef R0
#undef R1
#undef R2
#undef hmS
#undef hmbS
#undef META_NR
#undef hmb
#undef bm
#undef um
#undef vm
#undef ym
#undef fm
#undef km
#undef vtm
#undef RS
}

extern "C" void kernel_launch(void* const* d_in, const int* in_sizes, int n_in, void* d_out, int out_size, void* d_ws, size_t ws_size, hipStream_t stream) {
    static int grid = 0;
    if (grid == 0) {
        if (n_in != 13 || in_sizes[0] != M * D || out_size != M * D || ws_size < WS_END) { fprintf(stderr, "kernel_launch: unexpected shapes (n_in %d, in0 %d, out %d, ws %zu); nothing launched\n", n_in, n_in > 0 ? in_sizes[0] : -1, out_size, ws_size); grid = -1; return; }
        int dev = 0, cus = 0, per_cu = 0;
        if (hipGetDevice(&dev) != hipSuccess || hipDeviceGetAttribute(&cus, hipDeviceAttributeMultiprocessorCount, dev) != hipSuccess) { grid = -1; return; }
        if (hipFuncSetAttribute((const void*)yoco_fwd, hipFuncAttributeMaxDynamicSharedMemorySize, LDS_BYTES) != hipSuccess) { fprintf(stderr, "kernel_launch: hipFuncSetAttribute failed\n"); grid = -1; return; }
        if (hipOccupancyMaxActiveBlocksPerMultiprocessor(&per_cu, (const void*)yoco_fwd, NWAVES * 64, LDS_BYTES) != hipSuccess || per_cu < 1)
            fprintf(stderr, "kernel_launch: note: occupancy query reports %d workgroups per CU\n", per_cu);
        (void)hipGetLastError();
        if (cus < 200) { fprintf(stderr, "kernel_launch: %d CUs: the epilogue exchange needs its four partner units within one round\n", cus); grid = -1; return; }
        grid = cus;
    }
    if (grid < 0) return;
    if (hipMemsetAsync((char*)d_ws + WS_CTL, 0, 64 * KiB, stream) != hipSuccess) return;
    Args a{};
    for (int i = 0; i < 13; ++i) a.in[i] = (const float*)d_in[i];
    a.out = (float*)d_out; a.ws = (unsigned char*)d_ws;
    hipLaunchKernelGGL(yoco_fwd, dim3(grid), dim3(NWAVES * 64), LDS_BYTES, stream, a);
}
```
